# Optimizing an MI355X kernel written in HIP

```python
import math
import jax, jax.numpy as jnp
from jax import lax
import numpy as np

D_MODEL = 1024
BATCH = 2
SEQ = 8192
DEPTH = 4

CHUNK = 64
N_A = DEPTH // 2
N_B = DEPTH - N_A
HGRN_EXPAND = 128
HGRN_HEADS = D_MODEL // 128
HGRN_FDIM = HGRN_HEADS * HGRN_EXPAND
HGRN_VDIM = D_MODEL // HGRN_HEADS
DIFF_HEADS = D_MODEL // 128
DIFF_HEAD_DIM = D_MODEL // DIFF_HEADS // 2
Q_BLOCK = 128
REL_BUCKETS = 32
REL_MAX_DIST = 128
D_FF = 4 * D_MODEL
EPS = 1e-6
NEG_INF = -1e30

kernel_name = "yoco_hgrn2_diffattn_trunk"


def rms_norm(x, w):
    xf = x.astype(jnp.float32)
    y = xf * lax.rsqrt(jnp.mean(xf * xf, axis=-1, keepdims=True) + EPS)
    return (y * w.astype(jnp.float32)).astype(x.dtype)


def squared_relu_mlp(h, w_up, w_down):
    u = jax.nn.relu(h @ w_up)
    return (u * u) @ w_down


def hgrn2_recurrence(q, k, log_f, v):
    B, S, H, dk = q.shape
    dv = v.shape[-1]
    n = S // CHUNK

    def to_chunks(t):
        return t.astype(jnp.float32).reshape(B, n, CHUNK, H, t.shape[-1]).transpose(1, 0, 3, 2, 4)

    causal = jnp.tril(jnp.ones((CHUNK, CHUNK), dtype=bool))[None, None, :, :, None]

    def step(state, inp):
        qc, kc, gc, vc = inp
        b = jnp.cumsum(gc, axis=2)
        o_inter = jnp.einsum('bhtk,bhkv->bhtv', qc * jnp.exp(b), state)
        diff = b[:, :, :, None, :] - b[:, :, None, :, :]
        decay = jnp.where(causal, jnp.exp(jnp.minimum(diff, 0.0)), 0.0)
        scores = jnp.einsum('bhtk,bhtsk,bhsk->bhts', qc, decay, kc)
        o = o_inter + jnp.einsum('bhts,bhsv->bhtv', scores, vc)
        b_last = b[:, :, -1:, :]
        state = jnp.exp(b_last[:, :, 0, :])[..., None] * state + jnp.einsum(
            'bhsk,bhsv->bhkv', kc * jnp.exp(b_last - b), vc)
        return state, o

    s0 = jnp.zeros((B, H, dk, dv), jnp.float32)
    _, o = lax.scan(step, s0, (to_chunks(q), to_chunks(k), to_chunks(log_f), to_chunks(v)))
    return o.transpose(1, 0, 3, 2, 4).reshape(B, S, H, dv)


def hgrn2_mixer(h, w_in, lb, gate_norm_w, w_out):
    B, S, _ = h.shape
    proj = h @ w_in
    q, f, i, g = jnp.split(proj, [HGRN_FDIM, 2 * HGRN_FDIM, 2 * HGRN_FDIM + D_MODEL], axis=-1)
    q = jax.nn.silu(q)
    f32 = f.astype(jnp.float32)
    log_f = jnp.logaddexp(jnp.log(lb), jnp.log1p(-lb) + jax.nn.log_sigmoid(f32))
    k = (1.0 - lb) * jax.nn.sigmoid(-f32)
    shp = (B, S, HGRN_HEADS, HGRN_EXPAND)
    o = hgrn2_recurrence(q.reshape(shp), k.reshape(shp), log_f.reshape(shp),
                         i.reshape(B, S, HGRN_HEADS, HGRN_VDIM))
    o = rms_norm(o, gate_norm_w) * jax.nn.silu(g.reshape(B, S, HGRN_HEADS, HGRN_VDIM).astype(jnp.float32))
    return o.reshape(B, S, D_MODEL).astype(h.dtype) @ w_out


def rel_bucket(rel):
    half = REL_BUCKETS // 2
    max_exact = half // 2
    ret = jnp.where(rel > 0, half, 0)
    n = jnp.abs(rel)
    nf = jnp.maximum(n, 1).astype(jnp.float32)
    large = max_exact + (jnp.log(nf / max_exact) / math.log(REL_MAX_DIST / max_exact)
                         * (half - max_exact)).astype(jnp.int32)
    large = jnp.minimum(large, half - 1)
    return ret + jnp.where(n < max_exact, n, large)


def diff_attention(q, k, v, rel_bias, lam):
    B, S, H, _, d = q.shape
    nblk = S // Q_BLOCK
    scale = d ** -0.5
    k_pos = jnp.arange(S)
    kf = k.astype(jnp.float32)
    vf = v.astype(jnp.float32)
    qb = q.reshape(B, nblk, Q_BLOCK, H, 2, d).transpose(1, 0, 2, 3, 4, 5)

    def block(args):
        idx, qblk = args
        q_pos = idx * Q_BLOCK + jnp.arange(Q_BLOCK)
        allowed = (k_pos[None, :] // CHUNK) <= (q_pos[:, None] // CHUNK)
        bias = rel_bias[rel_bucket(k_pos[None, :] - q_pos[:, None])]
        bias = bias.reshape(Q_BLOCK, S, H, 2).transpose(2, 3, 0, 1).astype(jnp.float32)
        logits = jnp.einsum('bqhmd,bshmd->bhmqs', qblk.astype(jnp.float32), kf) * scale + bias
        logits = jnp.where(allowed, logits, NEG_INF)
        p = jax.nn.softmax(logits, axis=-1)
        attn = p[:, :, 0] - lam * p[:, :, 1]
        return jnp.einsum('bhqs,bshe->bqhe', attn, vf)

    o = lax.map(block, (jnp.arange(nblk), qb))
    return o.transpose(1, 0, 2, 3, 4).reshape(B, S, H, 2 * d)


def diff_attn_mixer(h, k, v, w_q, lam_params, subln_w, w_out, rel_bias, lam_init):
    B, S, _ = h.shape
    q = (h @ w_q).reshape(B, S, DIFF_HEADS, 2, DIFF_HEAD_DIM)
    lp = lam_params.astype(jnp.float32)
    lam = jnp.exp(jnp.sum(lp[0] * lp[1])) - jnp.exp(jnp.sum(lp[2] * lp[3])) + lam_init
    o = diff_attention(q, k, v, rel_bias, lam)
    o = rms_norm(o, subln_w) * (1.0 - lam_init)
    return o.reshape(B, S, D_MODEL).astype(h.dtype) @ w_out


def shared_kv(h, kv_norm, w_kv):
    B, S, _ = h.shape
    kv = rms_norm(h, kv_norm) @ w_kv
    k = kv[..., :D_MODEL].reshape(B, S, DIFF_HEADS, 2, DIFF_HEAD_DIM)
    v = kv[..., D_MODEL:].reshape(B, S, DIFF_HEADS, 2 * DIFF_HEAD_DIM)
    return k, v


def setup_inputs(seed: int = 0) -> dict:
    key = jax.random.key(seed)
    ks = jax.random.split(key, 24)
    D = D_MODEL

    def w(k, shape, fan_in):
        return jax.random.normal(k, shape, jnp.float32) * fan_in ** -0.5

    def gain(k, shape):
        return 1.0 + 0.05 * jax.random.normal(k, shape, jnp.float32)

    return {
        "x": jax.random.normal(ks[0], (BATCH, SEQ, D), jnp.float32),
        "a_norm_pre": gain(ks[1], (N_A, D)),
        "a_norm_post": gain(ks[2], (N_A, D)),
        "a_w_in": w(ks[3], (N_A, D, 2 * HGRN_FDIM + 2 * D), D),
        "a_lb": 0.1 * jax.random.normal(ks[4], (N_A, HGRN_FDIM), jnp.float32),
        "a_gate_norm": gain(ks[5], (N_A, HGRN_VDIM)),
        "a_w_out": w(ks[6], (N_A, D, D), D),
        "kv_norm": gain(ks[7], (D,)),
        "w_kv": w(ks[8], (D, 2 * D), D),
        "b_norm_pre": gain(ks[9], (N_B, D)),
        "b_norm_post": gain(ks[10], (N_B, D)),
        "b_w_q": w(ks[11], (N_B, D, D), D),
        "b_lambda": 0.1 * jax.random.normal(ks[12], (N_B, 4, DIFF_HEAD_DIM), jnp.float32),
        "b_subln": gain(ks[13], (N_B, 2 * DIFF_HEAD_DIM)),
        "b_w_out": w(ks[14], (N_B, D, D), D),
        "rel_bias": 0.2 * jax.random.normal(ks[15], (REL_BUCKETS, 2 * DIFF_HEADS), jnp.float32),
        "mlp_norm_pre": gain(ks[16], (DEPTH, D)),
        "mlp_norm_post": gain(ks[17], (DEPTH, D)),
        "mlp_w_up": w(ks[18], (DEPTH, D, D_FF), D),
        "mlp_w_down": w(ks[19], (DEPTH, D_FF, D), D_FF),
    }


def reference(x, a_norm_pre, a_norm_post, a_w_in, a_lb, a_gate_norm, a_w_out, kv_norm, w_kv,
              b_norm_pre, b_norm_post, b_w_q, b_lambda, b_subln, b_w_out, rel_bias,
              mlp_norm_pre, mlp_norm_post, mlp_w_up, mlp_w_down):
    lb_all = jnp.cumsum(jax.nn.softmax(a_lb.astype(jnp.float32), axis=0), axis=0)
    lb_all = lb_all - lb_all[0:1]
    h = x
    k_sh = None
    v_sh = None
    for layer in range(DEPTH):
        if layer < N_A:
            a = layer
            mix = hgrn2_mixer(rms_norm(h, a_norm_pre[a]), a_w_in[a], lb_all[a], a_gate_norm[a], a_w_out[a])
            h = h + rms_norm(mix, a_norm_post[a])
        else:
            bi = layer - N_A
            lam_init = 0.8 - 0.6 * math.exp(-0.3 * layer)
            mix = diff_attn_mixer(rms_norm(h, b_norm_pre[bi]), k_sh, v_sh, b_w_q[bi], b_lambda[bi],
                                  b_subln[bi], b_w_out[bi], rel_bias, lam_init)
            h = h + rms_norm(mix, b_norm_post[bi])
        ff = squared_relu_mlp(rms_norm(h, mlp_norm_pre[layer]), mlp_w_up[layer], mlp_w_down[layer])
        h = h + rms_norm(ff, mlp_norm_post[layer])
        if layer == N_A - 1:
            k_sh, v_sh = shared_kv(h, kv_norm, w_kv)
    return h
```

```cpp
#include <hip/hip_runtime.h>
#include <hip/hip_cooperative_groups.h>
#include <hip/hip_bf16.h>
#include <cstdio>
#include <cstdint>
#include <cmath>
namespace cg = cooperative_groups;
#define N_LAUNCH_MODE 0
namespace pg8 {
#define PG8_LAS __attribute__((address_space(3)))
typedef unsigned short bf16_t;
typedef short bf16x8 __attribute__((ext_vector_type(8)));
typedef float f32x4 __attribute__((ext_vector_type(4)));
typedef unsigned u32x4 __attribute__((ext_vector_type(4)));
constexpr int BM = 256, BK = 64, HALF = 128, HTB = HALF * BK * 2  , STAGE_BYTES = 8 * HTB, NXCD = 8, WGM = 8;

__host__ __device__ __forceinline__ int lds_byte(int r, int c) { const int st = (r >> 4) * 2 + (c >> 5), rr = r & 15, cc = c & 31, ob = rr * 64 + cc * 2; return st * 1024 + (ob ^ (((ob >> 9) & 1) << 5)); }
__host__ __device__ __forceinline__ void stage_rc(int b, int& R, int& C) { const int st = b / 1024, sb = b % 1024, swz = sb ^ (((sb >> 9) & 1) << 5); R = (st >> 1) * 16 + swz / 64; C = (st & 1) * 32 + (swz % 64) / 2; }
__host__ __device__ __forceinline__ int perm32(int rho) { const int n = rho >> 4, i = rho & 15; return 8 * (i >> 2) + 4 * n + (i & 3); }

struct Unit { int pm, pn; };
struct Gemm { const bf16_t* A; const bf16_t* Bt; int M, N, K; };

struct StaticOrder {
    int nM, nN, nwg, G, c;
    __host__ __device__ void init(int M, int N, int G_, int c_) { nM = M / BM; nN = N / BM; nwg = nM * nN; G = G_; c = c_; }
    __host__ __device__ bool next(int i, Unit& u) const {
        const long L = (long)i * G + c; if (L >= nwg) return false;
        int wgid = (int)L; { const int q = nwg / NXCD, r = nwg % NXCD, xcd = wgid % NXCD, off = wgid / NXCD; wgid = (xcd < r ? xcd * (q + 1) : r * (q + 1) + (xcd - r) * q) + off; }
        const int nig = WGM * nN, gid = wgid / nig, fm = gid * WGM, gsz = (nM - fm) < WGM ? (nM - fm) : WGM;
        u.pm = fm + ((wgid % nig) % gsz); u.pn = (wgid % nig) / gsz; return true;
    }
    __device__ __forceinline__ void a_ready(const Unit&) const {}
    __device__ __forceinline__ void done(const Unit&) const {}
};

__device__ __forceinline__ unsigned cvt_pk_bf16(float lo, float hi) { unsigned r; asm volatile("v_cvt_pk_bf16_f32 %0, %1, %2" : "=v"(r) : "v"(lo), "v"(hi)); return r; }
typedef float f32x2 __attribute__((ext_vector_type(2)));
template <class Epi, class Sched, bool ALIGN_EPI = false, bool SP2 = false>
__device__ __forceinline__ void gemm_phase(PG8_LAS unsigned char* lds, const Gemm g, const Sched& S, const Epi& E, const int tid_in) {
    const int tid = tid_in, wid = __builtin_amdgcn_readfirstlane(tid >> 6), lane = tid & 63, wr = wid >> 2, wc = wid & 3, fr = lane & 15, fq = lane >> 4;
    const int K = g.K, nt = K / BK;
    unsigned voffA[2], voffB[2];
#pragma unroll
    for (int i = 0; i < 2; ++i) { int R, C; stage_rc(tid * 16 + i * 8192, R, C); const int Rb = Epi::PERM ? ((R & ~31) + perm32(R & 31)) : R;
        voffA[i] = (unsigned)(R * K + C) * 2u; voffB[i] = (unsigned)(Rb * K + C) * 2u; }
    const size_t kstep = (size_t)(BK * 2);
    const size_t hstep = (size_t)HALF * K * 2;
    const size_t tstep = 2 * hstep;
    const unsigned ldsw = (unsigned)wid * 1024u;
    const int aoff = lds_byte(wr * 64 + fr, fq * 8), boff = lds_byte(wc * 32 + fr, fq * 8);
#define PG8_SA(b, h) (((b) * 2 + (h)) * HTB)
#define PG8_SB(b, h) ((4 + (b) * 2 + (h)) * HTB)
#define PG8_STAGE(bufoff, gbase, voff) do { _Pragma("unroll") for (int _i = 0; _i < 2; ++_i) \
        __builtin_amdgcn_global_load_lds((const unsigned*)((const char*)(gbase) + (voff)[_i]), (PG8_LAS unsigned*)(lds + (bufoff) + ldsw + _i * 8192), 16, 0, 0); } while (0)
#define PG8_LDA(dst, b, h) do { _Pragma("unroll") for (int m = 0; m < 4; ++m) _Pragma("unroll") for (int k = 0; k < 2; ++k) dst[m][k] = *(const PG8_LAS bf16x8*)(lds + PG8_SA(b, h) + aoff + m * 2048 + k * 1024); } while (0)
#define PG8_LDB(dst, b, h) do { _Pragma("unroll") for (int n = 0; n < 2; ++n) _Pragma("unroll") for (int k = 0; k < 2; ++k) dst[n][k] = *(const PG8_LAS bf16x8*)(lds + PG8_SB(b, h) + boff + n * 2048 + k * 1024); } while (0)
#define PG8_MMA(ai, bj, At, Bt) do { __builtin_amdgcn_s_setprio(1); _Pragma("unroll") for (int m = 0; m < 4; ++m) _Pragma("unroll") for (int n = 0; n < 2; ++n) _Pragma("unroll") for (int k = 0; k < 2; ++k) \
        acc[ai][bj][m][n] = __builtin_amdgcn_mfma_f32_16x16x32_bf16(Bt[n][k], At[m][k], acc[ai][bj][m][n], 0, 0, 0); __builtin_amdgcn_s_setprio(0); } while (0)
#define PG8_WAIT_V(n) asm volatile("s_waitcnt vmcnt(" #n ")" ::: "memory")
#define PG8_WAIT_L(n) asm volatile("s_waitcnt lgkmcnt(" #n ")" ::: "memory")
#define PG8_BAR __builtin_amdgcn_s_barrier()
#define PG8_SCHED __builtin_amdgcn_sched_barrier(0)
    Unit cur, nxt; int ui = 0;
    if (!S.next(0, cur)) return;
    f32x4 acc[2][2][4][2];
#pragma unroll
    for (int a = 0; a < 2; ++a)
#pragma unroll
        for (int b = 0; b < 2; ++b)
#pragma unroll
            for (int m = 0; m < 4; ++m)
#pragma unroll
                for (int n = 0; n < 2; ++n) acc[a][b][m][n] = (f32x4){0.f, 0.f, 0.f, 0.f};
    bf16x8 At[4][2], B0[2][2], B1[2][2];
    const char* cA = (const char*)g.A + (size_t)cur.pm * tstep; const char* cB = (const char*)g.Bt + (size_t)cur.pn * tstep;
    S.a_ready(cur);
    if constexpr (SP2) {
        PG8_STAGE(PG8_SB(0, 0), cB, voffB); PG8_STAGE(PG8_SB(0, 1), cB + hstep, voffB); PG8_STAGE(PG8_SA(0, 0), cA, voffA); PG8_STAGE(PG8_SA(0, 1), cA + hstep, voffA);
        if (wr == 1) PG8_BAR;
        PG8_WAIT_V(2); PG8_BAR;
        PG8_STAGE(PG8_SB(1, 0), cB + kstep, voffB); PG8_STAGE(PG8_SA(1, 0), cA + kstep, voffA); PG8_STAGE(PG8_SB(1, 1), cB + hstep + kstep, voffB);
        PG8_WAIT_V(6); PG8_BAR;
    } else {
        PG8_STAGE(PG8_SB(0, 0), cB, voffB); PG8_STAGE(PG8_SA(0, 0), cA, voffA); PG8_STAGE(PG8_SB(0, 1), cB + hstep, voffB); PG8_STAGE(PG8_SA(0, 1), cA + hstep, voffA);
        if (wr == 1) PG8_BAR;
        PG8_WAIT_V(4); PG8_BAR;
        PG8_STAGE(PG8_SB(1, 0), cB + kstep, voffB); PG8_STAGE(PG8_SA(1, 0), cA + kstep, voffA); PG8_STAGE(PG8_SB(1, 1), cB + hstep + kstep, voffB);
        PG8_WAIT_V(6); PG8_BAR;
    }
    for (;;) {
        const bool has_next = S.next(ui + 1, nxt);
        const char* nA = has_next ? (const char*)g.A + (size_t)nxt.pm * tstep : cA; const char* nB = has_next ? (const char*)g.Bt + (size_t)nxt.pn * tstep : cB;
        for (int t = 0; t < nt; t += 2) {
            const bool last = (t == nt - 2);
            const char* a1 = cA + (size_t)(t + 1) * kstep;
            const char* a2 = last ? nA : cA + (size_t)(t + 2) * kstep; const char* b2 = last ? nB : cB + (size_t)(t + 2) * kstep;
            const char* a3 = a2 + kstep; const char* b3 = b2 + kstep;
            if (last && has_next) S.a_ready(nxt);
            if constexpr (SP2) {
            PG8_LDB(B0, 0, 0); PG8_LDB(B1, 0, 1); PG8_SCHED; PG8_LDA(At, 0, 0); PG8_STAGE(PG8_SA(1, 1), a1 + hstep, voffA);
            PG8_WAIT_V(8); PG8_WAIT_L(0); PG8_BAR; PG8_MMA(0, 0, At, B0); PG8_MMA(0, 1, At, B1); PG8_BAR; PG8_SCHED;
            PG8_LDA(At, 0, 1); PG8_STAGE(PG8_SB(0, 0), b2, voffB); PG8_STAGE(PG8_SB(0, 1), b2 + hstep, voffB); PG8_STAGE(PG8_SA(0, 0), a2, voffA);
            PG8_WAIT_V(8); PG8_WAIT_L(0); PG8_BAR; PG8_MMA(1, 0, At, B0); PG8_MMA(1, 1, At, B1); PG8_BAR; PG8_SCHED;
            PG8_LDB(B0, 1, 0); PG8_LDB(B1, 1, 1); PG8_SCHED; PG8_LDA(At, 1, 0); PG8_STAGE(PG8_SA(0, 1), a2 + hstep, voffA);
            PG8_WAIT_V(8); PG8_WAIT_L(0); PG8_BAR; PG8_MMA(0, 0, At, B0); PG8_MMA(0, 1, At, B1); PG8_BAR; PG8_SCHED;
            PG8_LDA(At, 1, 1); PG8_STAGE(PG8_SB(1, 0), b3, voffB); PG8_STAGE(PG8_SB(1, 1), b3 + hstep, voffB); PG8_STAGE(PG8_SA(1, 0), a3, voffA);
            PG8_WAIT_V(8); PG8_WAIT_L(0); PG8_BAR; PG8_MMA(1, 0, At, B0); PG8_MMA(1, 1, At, B1); PG8_BAR; PG8_SCHED;
            } else {
            PG8_LDB(B0, 0, 0); PG8_SCHED; PG8_LDA(At, 0, 0); PG8_STAGE(PG8_SA(1, 1), a1 + hstep, voffA);
            PG8_WAIT_L(8); PG8_BAR; PG8_WAIT_L(0); PG8_MMA(0, 0, At, B0); PG8_BAR; PG8_SCHED;
            PG8_LDB(B1, 0, 1); PG8_STAGE(PG8_SB(0, 0), b2, voffB);
            PG8_BAR; PG8_WAIT_L(0); PG8_MMA(0, 1, At, B1); PG8_BAR;
            PG8_LDA(At, 0, 1); PG8_STAGE(PG8_SA(0, 0), a2, voffA);
            PG8_BAR; PG8_WAIT_L(0); PG8_MMA(1, 0, At, B0); PG8_BAR; PG8_SCHED;
            PG8_STAGE(PG8_SB(0, 1), b2 + hstep, voffB);
            PG8_WAIT_V(6); PG8_BAR; PG8_MMA(1, 1, At, B1); PG8_BAR;
            PG8_LDB(B0, 1, 0); PG8_SCHED; PG8_LDA(At, 1, 0); PG8_STAGE(PG8_SA(0, 1), a2 + hstep, voffA);
            PG8_WAIT_L(8); PG8_BAR; PG8_WAIT_L(0); PG8_MMA(0, 0, At, B0); PG8_BAR; PG8_SCHED;
            PG8_LDB(B1, 1, 1); PG8_STAGE(PG8_SB(1, 0), b3, voffB);
            PG8_BAR; PG8_WAIT_L(0); PG8_MMA(0, 1, At, B1); PG8_BAR;
            PG8_LDA(At, 1, 1); PG8_STAGE(PG8_SA(1, 0), a3, voffA);
            PG8_BAR; PG8_WAIT_L(0); PG8_MMA(1, 0, At, B0); PG8_BAR; PG8_SCHED;
            PG8_STAGE(PG8_SB(1, 1), b3 + hstep, voffB);
            PG8_WAIT_V(6); PG8_BAR; PG8_MMA(1, 1, At, B1); PG8_BAR;
            }
        }
        if constexpr (ALIGN_EPI) { if (wr == 0) PG8_BAR; }
        if constexpr (!Epi::AFTER_DRAIN) { E(acc, cur, wr, wc, fr, fq); S.done(cur); }
        if (!has_next) break;
#pragma unroll
        for (int a = 0; a < 2; ++a)
#pragma unroll
            for (int b = 0; b < 2; ++b)
#pragma unroll
                for (int m = 0; m < 4; ++m)
#pragma unroll
                    for (int n = 0; n < 2; ++n) acc[a][b][m][n] = (f32x4){0.f, 0.f, 0.f, 0.f};
        cur = nxt; cA = nA; cB = nB; ++ui;
        if constexpr (ALIGN_EPI) { if (wr == 1) PG8_BAR; }
    }
    PG8_WAIT_V(0);
    if constexpr (!ALIGN_EPI) { if (wr == 0) PG8_BAR; }
    PG8_BAR;
    if constexpr (Epi::AFTER_DRAIN) { E.fused(acc, cur, wr, wc, fr, fq, lds, wid, lane); S.done(cur); }
#undef PG8_SA
#undef PG8_SB
#undef PG8_STAGE
#undef PG8_LDA
#undef PG8_LDB
#undef PG8_MMA
#undef PG8_WAIT_V
#undef PG8_WAIT_L
#undef PG8_BAR
#undef PG8_SCHED
}
}
#define LAS __attribute__((address_space(3)))
#define GAS __attribute__((address_space(1)))
#define GP(T, p) ((T*)(GAS T*)(p))
typedef unsigned short bf16;
typedef unsigned u32x4v __attribute__((ext_vector_type(4)));
typedef unsigned u32x2v __attribute__((ext_vector_type(2)));
typedef float f32x4 __attribute__((ext_vector_type(4)));
typedef float f32x2 __attribute__((ext_vector_type(2)));
typedef float f32x16 __attribute__((ext_vector_type(16)));
typedef short bf16x8 __attribute__((ext_vector_type(8)));
typedef short s16x4 __attribute__((ext_vector_type(4)));
typedef __bf16 bf16x2_t __attribute__((ext_vector_type(2)));

constexpr int M = 16384, D = 1024, SEQ = 8192, FF = 4096;
constexpr float EPS = 1e-6f;
constexpr float LOG2E = 1.4426950408889634f;
constexpr float QSCALE = 0.125f * LOG2E;

constexpr size_t MiB = 1u << 20;
constexpr size_t WS_CTL = 0, WS_STAT = 1 * MiB, WS_W = 2 * MiB, WS_XN = 28 * MiB, WS_UX = 60 * MiB, WS_Q = 92 * MiB, WS_V = 124 * MiB,
                 WS_GATE = 156 * MiB, WS_G = 188 * MiB, WS_HID = 92 * MiB, WS_VB = 220 * MiB, WS_U = 28 * MiB;
constexpr size_t W_A = 0, W_O = 8 * MiB, W_U = 10 * MiB, W_D = 18 * MiB;
constexpr size_t CTL_LBT = 0, CTL_BT = 65536, CTL_LAM = 98304, CTL_BAR = 131072, CTL_CNT = 262144  , CTL_ZERO_END = 524288;

constexpr int LDS_TOTAL = 131072 + 1024;

enum { K_PRO = 0, K_WIN, K_HA, K_HB, K_HC, K_YOUT, K_NORM1, K_UP, K_DOWN, K_NORM2, K_KVQ, K_QG, K_ATT, K_YOUTF, K_DOWNF, K_CONV };

struct Args { const float* in[20]; float* out; unsigned char* ws; int lo, hi; unsigned char kind[80]; unsigned char layer[80]; unsigned char cv[80]; };

__device__ __forceinline__ unsigned pk2(float lo, float hi) { f32x2 v = {lo, hi}; bf16x2_t b = __builtin_convertvector(v, bf16x2_t); return __builtin_bit_cast(unsigned, b); }
typedef _Float16 f16x2_t __attribute__((ext_vector_type(2)));
__device__ __forceinline__ unsigned pkh2(float lo, float hi) { f16x2_t v = {(_Float16)lo, (_Float16)hi}; return __builtin_bit_cast(unsigned, v); }
__device__ __forceinline__ float hlo(unsigned u) { return (float)__builtin_bit_cast(f16x2_t, u)[0]; }
__device__ __forceinline__ float hhi(unsigned u) { return (float)__builtin_bit_cast(f16x2_t, u)[1]; }
__device__ __forceinline__ float bflo(unsigned u) { return __uint_as_float(u << 16); }
__device__ __forceinline__ float bfhi(unsigned u) { return __uint_as_float(u & 0xffff0000u); }
__device__ __forceinline__ int crow(int r, int hi) { return (r & 3) + 8 * (r >> 2) + 4 * hi; }
__device__ __forceinline__ float wave_sum(float v) {
#pragma unroll
    for (int o = 1; o < 64; o <<= 1) v += __shfl_xor(v, o);
    return v;
}
#define MFMA32(a, b, c) __builtin_amdgcn_mfma_f32_32x32x16_bf16((a), (b), (c), 0, 0, 0)
#define MFMA16(a, b, c) __builtin_amdgcn_mfma_f32_16x16x32_bf16((a), (b), (c), 0, 0, 0)

struct EpiSplit {
    static constexpr bool PERM = true, AFTER_DRAIN = false;
    unsigned char* ws; int kvq;
    __device__ __forceinline__ void operator()(const pg8::f32x4 (&acc)[2][2][4][2], const pg8::Unit& u, int wr, int wc, int fr, int fq) const {
        const int seg = u.pn >> 2; size_t off = WS_Q; if (kvq && seg == 0) off = WS_UX; if (kvq && seg == 1) off = WS_VB;
        bf16* base = (bf16*)(ws + off);
        const int row0 = u.pm * 256 + wr * 64 + fr, col0 = (u.pn & 3) * 256 + wc * 32 + 8 * fq;
#pragma unroll
        for (int ai = 0; ai < 2; ++ai)
#pragma unroll
            for (int m = 0; m < 4; ++m) { bf16* rowp = base + (size_t)(row0 + ai * 128 + m * 16) * 1024 + col0;
#pragma unroll
                for (int bj = 0; bj < 2; ++bj) { const pg8::f32x4 v0 = acc[ai][bj][m][0], v1 = acc[ai][bj][m][1];
                    u32x4v w; w.x = pk2(v0[0], v0[1]); w.y = pk2(v0[2], v0[3]); w.z = pk2(v1[0], v1[1]); w.w = pk2(v1[2], v1[3]);
                    *(u32x4v*)(rowp + bj * 128) = w; } }
    }
};
struct EpiRelu2 {
    static constexpr bool PERM = true, AFTER_DRAIN = false;
    bf16* O;
    __device__ __forceinline__ void operator()(const pg8::f32x4 (&acc)[2][2][4][2], const pg8::Unit& u, int wr, int wc, int fr, int fq) const {
        const int row0 = u.pm * 256 + wr * 64 + fr, col0 = u.pn * 256 + wc * 32 + 8 * fq;
#pragma unroll
        for (int ai = 0; ai < 2; ++ai)
#pragma unroll
            for (int m = 0; m < 4; ++m) { bf16* rowp = O + (size_t)(row0 + ai * 128 + m * 16) * FF + col0;
#pragma unroll
                for (int bj = 0; bj < 2; ++bj) { pg8::f32x4 v0 = acc[ai][bj][m][0], v1 = acc[ai][bj][m][1];
#pragma unroll
                    for (int e = 0; e < 4; ++e) { const float a = fmaxf(v0[e], 0.f), b = fmaxf(v1[e], 0.f); v0[e] = a * a; v1[e] = b * b; }
                    u32x4v w; w.x = pk2(v0[0], v0[1]); w.y = pk2(v0[2], v0[3]); w.z = pk2(v1[0], v1[1]); w.w = pk2(v1[2], v1[3]);
                    *(u32x4v*)(rowp + bj * 128) = w; } }
    }
};
struct EpiY {
    static constexpr bool PERM = true, AFTER_DRAIN = false;
    bf16* O; float* stat;
    __device__ __forceinline__ void operator()(const pg8::f32x4 (&acc)[2][2][4][2], const pg8::Unit& u, int wr, int wc, int fr, int fq) const {
        const int row0 = u.pm * 256 + wr * 64 + fr, col0 = u.pn * 256 + wc * 32 + 8 * fq;
#pragma unroll
        for (int ai = 0; ai < 2; ++ai)
#pragma unroll
            for (int m = 0; m < 4; ++m) { const int row = row0 + ai * 128 + m * 16; bf16* rowp = O + (size_t)row * 1024 + col0; float ss = 0.f;
#pragma unroll
                for (int bj = 0; bj < 2; ++bj) { const pg8::f32x4 v0 = acc[ai][bj][m][0], v1 = acc[ai][bj][m][1];
                    ss += (v0[0] * v0[0] + v0[1] * v0[1]) + (v0[2] * v0[2] + v0[3] * v0[3]) + (v1[0] * v1[0] + v1[1] * v1[1]) + (v1[2] * v1[2] + v1[3] * v1[3]);
                    u32x4v w; w.x = pk2(v0[0], v0[1]); w.y = pk2(v0[2], v0[3]); w.z = pk2(v1[0], v1[1]); w.w = pk2(v1[2], v1[3]);
                    *(u32x4v*)(rowp + bj * 128) = w; }
                ss += __shfl_xor(ss, 16); ss += __shfl_xor(ss, 32);
                if (fq == 0) stat[(size_t)row * 16 + u.pn * 4 + wc] = ss; }
    }
};
__device__ __forceinline__ float silu_f(float x) { return x * __builtin_amdgcn_rcpf(1.f + __expf(-x)); }
struct EpiWin {
    static constexpr bool PERM = true, AFTER_DRAIN = false;
    unsigned char* ws; const float* lbt;
    __device__ __forceinline__ void operator()(const pg8::f32x4 (&acc)[2][2][4][2], const pg8::Unit& u, int wr, int wc, int fr, int fq) const {
        const int seg = u.pn >> 2;
        const int row0 = u.pm * 256 + wr * 64 + fr, col0 = (u.pn & 3) * 256 + wc * 32 + 8 * fq;
        if (seg == 1) {
#pragma unroll
            for (int bj = 0; bj < 2; ++bj) {
                float la[8], l1[8];
#pragma unroll
                for (int e = 0; e < 8; e += 2) { const f32x4 t = *(const f32x4*)(lbt + (size_t)(col0 + bj * 128 + e) * 2); la[e] = t[0]; l1[e] = t[1]; la[e + 1] = t[2]; l1[e + 1] = t[3]; }
#pragma unroll
                for (int ai = 0; ai < 2; ++ai)
#pragma unroll
                    for (int m = 0; m < 4; ++m) { bf16* rowp = (bf16*)(ws + WS_G) + (size_t)(row0 + ai * 128 + m * 16) * 1024 + col0 + bj * 128;
                        float o[8];
#pragma unroll
                        for (int n = 0; n < 2; ++n) { const pg8::f32x4 v = acc[ai][bj][m][n];
#pragma unroll
                            for (int e = 0; e < 4; ++e) { const float f = v[e];
                                const float ls = fminf(f, 0.f) - __logf(1.f + __expf(-fabsf(f)));
                                const float c = l1[4 * n + e] + ls, a = la[4 * n + e];
                                const float mx = fmaxf(a, c), df = fabsf(a - c);
                                o[4 * n + e] = mx + __logf(1.f + __expf(-df)); } }
                        u32x4v w; w.x = pkh2(o[0], o[1]); w.y = pkh2(o[2], o[3]); w.z = pkh2(o[4], o[5]); w.w = pkh2(o[6], o[7]);
                        *(u32x4v*)rowp = w; }
            }
        } else {
            size_t off = WS_Q; if (seg == 2) off = WS_V; if (seg == 3) off = WS_GATE; bf16* base = (bf16*)(ws + off);
#pragma unroll
            for (int ai = 0; ai < 2; ++ai)
#pragma unroll
                for (int m = 0; m < 4; ++m) { bf16* rowp = base + (size_t)(row0 + ai * 128 + m * 16) * 1024 + col0;
#pragma unroll
                    for (int bj = 0; bj < 2; ++bj) { pg8::f32x4 v0 = acc[ai][bj][m][0], v1 = acc[ai][bj][m][1];
                        if (seg != 2) {
#pragma unroll
                            for (int e = 0; e < 4; ++e) { v0[e] = silu_f(v0[e]); v1[e] = silu_f(v1[e]); } }
                        u32x4v w; w.x = pk2(v0[0], v0[1]); w.y = pk2(v0[2], v0[3]); w.z = pk2(v1[0], v1[1]); w.w = pk2(v1[2], v1[3]);
                        *(u32x4v*)(rowp + bj * 128) = w; } }
        }
    }
};

struct RowStatX {
    float* xbuf;
    unsigned* cnt;
    __device__ __forceinline__ void run(const pg8::f32x4 (&v)[2][2][4][2], const pg8::Unit& u, int wr, int wc, int fr, int fq, LAS unsigned char* lds, int wid, int lane) const {
        LAS float* P = (LAS float*)lds; LAS float* S = (LAS float*)(lds + 4096);
        const int tid = wid * 64 + lane;
#pragma unroll
        for (int ai = 0; ai < 2; ++ai)
#pragma unroll
            for (int m = 0; m < 4; ++m) { float s = 0.f;
#pragma unroll
                for (int bj = 0; bj < 2; ++bj)
#pragma unroll
                    for (int n = 0; n < 2; ++n) { const pg8::f32x4 x = v[ai][bj][m][n]; s += (x[0] * x[0] + x[1] * x[1]) + (x[2] * x[2] + x[3] * x[3]); }
                s += __shfl_xor(s, 16); s += __shfl_xor(s, 32);
                if (fq == 0) P[(ai * 128 + wr * 64 + m * 16 + fr) * 4 + wc] = s; }
        asm volatile("s_waitcnt lgkmcnt(0)" ::: "memory"); __builtin_amdgcn_s_barrier(); asm volatile("" ::: "memory");
        if (tid < 256) { const f32x4 p = *(const LAS f32x4*)(P + tid * 4);
            __hip_atomic_store(xbuf + (size_t)(u.pm * 256 + tid) * 4 + u.pn, (p[0] + p[1]) + (p[2] + p[3]), __ATOMIC_RELAXED, __HIP_MEMORY_SCOPE_AGENT); }
        asm volatile("s_waitcnt vmcnt(0)" ::: "memory");
        if (lane == 0) __hip_atomic_fetch_add(cnt + 64 * u.pm, 1u, __ATOMIC_RELAXED, __HIP_MEMORY_SCOPE_AGENT);
        if (wid == 0) {
            unsigned spins = 0;
            while ((unsigned)__builtin_amdgcn_readfirstlane(__hip_atomic_load(cnt + 64 * u.pm, __ATOMIC_RELAXED, __HIP_MEMORY_SCOPE_AGENT)) < 32u) { __builtin_amdgcn_s_sleep(2); if (++spins > (1u << 22)) break; }
            __builtin_amdgcn_fence(__ATOMIC_ACQUIRE, "agent");
        }
        asm volatile("s_waitcnt vmcnt(0) lgkmcnt(0)" ::: "memory"); __builtin_amdgcn_s_barrier(); asm volatile("" ::: "memory");
        if (tid < 256) { const float* slot = xbuf + (size_t)(u.pm * 256 + tid) * 4; float t = 0.f;
#pragma unroll
            for (int j = 0; j < 4; ++j) t += __hip_atomic_load(slot + j, __ATOMIC_RELAXED, __HIP_MEMORY_SCOPE_AGENT);
            S[tid] = rsqrtf(t * (1.f / 1024.f) + EPS); }
        asm volatile("s_waitcnt lgkmcnt(0)" ::: "memory"); __builtin_amdgcn_s_barrier(); asm volatile("" ::: "memory");
    }
};
struct EpiNormF {
    static constexpr bool PERM = false, AFTER_DRAIN = true;
    const float* hin; float* hout; bf16* xn; const float* wpost; RowStatX st1, st2;
    __device__ __forceinline__ void fused(pg8::f32x4 (&acc)[2][2][4][2], const pg8::Unit& u, int wr, int wc, int fr, int fq, LAS unsigned char* lds, int wid, int lane) const {
        const LAS float* S = (const LAS float*)(lds + 4096);
        const int col0 = u.pn * 256 + wc * 32 + 4 * fq;
        f32x4 pre[4][2][2];
#pragma unroll
        for (int m = 0; m < 4; ++m) { const size_t off = (size_t)(u.pm * 256 + wr * 64 + m * 16 + fr) * 1024 + col0;
#pragma unroll
            for (int bj = 0; bj < 2; ++bj)
#pragma unroll
                for (int n = 0; n < 2; ++n) pre[m][bj][n] = *(const f32x4*)(hin + off + bj * 128 + n * 16); }
        st1.run(acc, u, wr, wc, fr, fq, lds, wid, lane);
        f32x4 w[2][2];
#pragma unroll
        for (int bj = 0; bj < 2; ++bj)
#pragma unroll
            for (int n = 0; n < 2; ++n) w[bj][n] = *(const f32x4*)(wpost + col0 + bj * 128 + n * 16);
#pragma unroll
        for (int ai = 0; ai < 2; ++ai)
#pragma unroll
            for (int m = 0; m < 4; ++m) { const int r = ai * 128 + wr * 64 + m * 16 + fr; const float rs = S[r]; const size_t off = (size_t)(u.pm * 256 + r) * 1024 + col0;
#pragma unroll
                for (int bj = 0; bj < 2; ++bj)
#pragma unroll
                    for (int n = 0; n < 2; ++n) { const f32x4 bs = ai == 0 ? pre[m][bj][n] : *(const f32x4*)(hin + off + bj * 128 + n * 16);
                        const f32x4 hn = bs + acc[ai][bj][m][n] * rs * w[bj][n]; acc[ai][bj][m][n] = hn; *(f32x4*)(hout + off + bj * 128 + n * 16) = hn; }
                if (m & 1) asm volatile("" ::: "memory"); }
        if (xn) {
            st2.run(acc, u, wr, wc, fr, fq, lds, wid, lane);
#pragma unroll
            for (int ai = 0; ai < 2; ++ai)
#pragma unroll
                for (int m = 0; m < 4; ++m) { const int r = ai * 128 + wr * 64 + m * 16 + fr; const float rs = S[r]; const size_t off = (size_t)(u.pm * 256 + r) * 1024 + col0;
#pragma unroll
                    for (int bj = 0; bj < 2; ++bj)
#pragma unroll
                        for (int n = 0; n < 2; ++n) { const f32x4 o = acc[ai][bj][m][n] * rs; u32x2v pk; pk.x = pk2(o[0], o[1]); pk.y = pk2(o[2], o[3]); *(u32x2v*)(xn + off + bj * 128 + n * 16) = pk; } }
        }
    }
};

struct Frame {
    unsigned char* lds; LAS unsigned char* lds3;
    int tid, lane, wave, G, bid;
    const float* const* in; float* H; unsigned char* ws;
};

__device__ __forceinline__ void cvt_job(const Frame& F, const float* W, int K, int N, bf16* WT, const float* gain, int kmask, float scale) {
    LAS float* scr = (LAS float*)(F.lds3);
    const int tid = F.tid, nblk = N / 128, items = (K / 64) * nblk;
    for (int item = F.bid; item < items; item += F.G) {
        const int kb = item / nblk, nb = item % nblk, k0 = 64 * kb, n0 = 128 * nb;
        f32x4 v[4];
#pragma unroll
        for (int i = 0; i < 4; ++i) { const int kk = 16 * i + (tid >> 5);
            v[i] = __builtin_nontemporal_load((const f32x4*)(W + (size_t)(k0 + kk) * N + n0 + 4 * (tid & 31))); }
#pragma unroll
        for (int i = 0; i < 4; ++i) { const int kk = 16 * i + (tid >> 5); const float g = gain ? gain[(k0 + kk) & kmask] * scale : scale;
            LAS float* p = scr + kk * 129 + 4 * (tid & 31);
            p[0] = v[i][0] * g; p[1] = v[i][1] * g; p[2] = v[i][2] * g; p[3] = v[i][3] * g; }
        __syncthreads();
#pragma unroll
        for (int j = 0; j < 2; ++j) { const int idx = tid + 512 * j, n = idx >> 3, c = idx & 7; const LAS float* sp = scr + (8 * c) * 129 + n;
            u32x4v o; o.x = pk2(sp[0 * 129], sp[1 * 129]); o.y = pk2(sp[2 * 129], sp[3 * 129]); o.z = pk2(sp[4 * 129], sp[5 * 129]); o.w = pk2(sp[6 * 129], sp[7 * 129]);
            *(u32x4v*)(WT + (size_t)(n0 + n) * K + k0 + 8 * c) = o; }
        __syncthreads();
    }
}
__device__ __forceinline__ float lam_init_of(int layer) { float c = 0.8f; asm volatile("" : "+v"(c)); return c - 0.6f * __expf(-0.3f * (float)layer); }
__device__ __forceinline__ void convert_layer(const Frame& F, int L, int mask) {
    bf16* WA = (bf16*)(F.ws + WS_W + W_A); bf16* WO = (bf16*)(F.ws + WS_W + W_O); bf16* WU = (bf16*)(F.ws + WS_W + W_U); bf16* WD = (bf16*)(F.ws + WS_W + W_D);
    if (L < 2) {
        if (mask & 1) cvt_job(F, F.in[3] + (size_t)L * D * 4096, D, 4096, WA, F.in[1] + L * D, 1023, 1.f);
        if (mask & 2) cvt_job(F, F.in[6] + (size_t)L * D * D, D, D, WO, F.in[5] + L * 128, 127, 1.f);
    } else {
        const int bi = L - 2;
        if (mask & 1) {
            if (bi == 0) {
                cvt_job(F, F.in[8], D, 2048, WA, F.in[7], 1023, 1.f);
                cvt_job(F, F.in[11], D, D, WA + (size_t)2048 * D, F.in[9], 1023, QSCALE);
            } else {
                cvt_job(F, F.in[11] + (size_t)bi * D * D, D, D, WA, F.in[9] + bi * D, 1023, QSCALE);
            }
        }
        if (mask & 2) cvt_job(F, F.in[14] + (size_t)bi * D * D, D, D, WO, F.in[13] + bi * 128, 127, 1.f - lam_init_of(L));
    }
    if (mask & 4) cvt_job(F, F.in[18] + (size_t)L * D * FF, D, FF, WU, F.in[16] + L * D, 1023, 1.f);
    if (mask & 8) cvt_job(F, F.in[19] + (size_t)L * FF * D, FF, D, WD, nullptr, 0, 1.f);
    __syncthreads();
}

#ifdef NORM2ROW
__device__ __forceinline__ void norm_pass(const Frame& F, const float* hin, const bf16* Y, const float* stat, const float* wpost, float* hout, bf16* xn) {
    const int gw = F.bid * 8 + F.wave, NGW = F.G * 8, lane = F.lane;
    f32x4 w[4];
    if (Y) { const float* wp = wpost + 8 * lane; w[0] = *(const f32x4*)wp; w[1] = *(const f32x4*)(wp + 4); w[2] = *(const f32x4*)(wp + 512); w[3] = *(const f32x4*)(wp + 516); }
    for (int row0 = gw; row0 < M; row0 += 2 * NGW) {
        f32x4 h[2][4]; u32x4v y0[2], y1[2]; float sp[2];
        const int row1 = row0 + NGW; const bool has1 = row1 < M;
#pragma unroll
        for (int q = 0; q < 2; ++q) { const int row = q ? (has1 ? row1 : row0) : row0;
            const float* hp = hin + (size_t)row * D + 8 * lane;
            h[q][0] = *(const f32x4*)(hp); h[q][1] = *(const f32x4*)(hp + 4); h[q][2] = *(const f32x4*)(hp + 512); h[q][3] = *(const f32x4*)(hp + 516);
            if (Y) { const bf16* yp = Y + (size_t)row * D + 8 * lane; y0[q] = *(const u32x4v*)yp; y1[q] = *(const u32x4v*)(yp + 512);
                sp[q] = (lane < 16) ? stat[(size_t)row * 16 + lane] : 0.f; } }
#pragma unroll
        for (int q = 0; q < 2; ++q) {
            if (q == 1 && !has1) break;
            const int row = q ? row1 : row0;
            if (Y) {
                const float rs = rsqrtf(wave_sum(sp[q]) * (1.f / 1024.f) + EPS);
                const u32x4v a = y0[q], b = y1[q];
                h[q][0][0] += bflo(a.x) * rs * w[0][0]; h[q][0][1] += bfhi(a.x) * rs * w[0][1]; h[q][0][2] += bflo(a.y) * rs * w[0][2]; h[q][0][3] += bfhi(a.y) * rs * w[0][3];
                h[q][1][0] += bflo(a.z) * rs * w[1][0]; h[q][1][1] += bfhi(a.z) * rs * w[1][1]; h[q][1][2] += bflo(a.w) * rs * w[1][2]; h[q][1][3] += bfhi(a.w) * rs * w[1][3];
                h[q][2][0] += bflo(b.x) * rs * w[2][0]; h[q][2][1] += bfhi(b.x) * rs * w[2][1]; h[q][2][2] += bflo(b.y) * rs * w[2][2]; h[q][2][3] += bfhi(b.y) * rs * w[2][3];
                h[q][3][0] += bflo(b.z) * rs * w[3][0]; h[q][3][1] += bfhi(b.z) * rs * w[3][1]; h[q][3][2] += bflo(b.w) * rs * w[3][2]; h[q][3][3] += bfhi(b.w) * rs * w[3][3];
            }
            if (hout) { float* op = hout + (size_t)row * D + 8 * lane;
                *(f32x4*)op = h[q][0]; *(f32x4*)(op + 4) = h[q][1]; *(f32x4*)(op + 512) = h[q][2]; *(f32x4*)(op + 516) = h[q][3]; }
            if (xn) {
                float ss = 0.f;
#pragma unroll
                for (int j = 0; j < 4; ++j) ss += (h[q][j][0] * h[q][j][0] + h[q][j][1] * h[q][j][1]) + (h[q][j][2] * h[q][j][2] + h[q][j][3] * h[q][j][3]);
                const float r = rsqrtf(wave_sum(ss) * (1.f / 1024.f) + EPS);
                u32x4v o0, o1;
                o0.x = pk2(h[q][0][0] * r, h[q][0][1] * r); o0.y = pk2(h[q][0][2] * r, h[q][0][3] * r); o0.z = pk2(h[q][1][0] * r, h[q][1][1] * r); o0.w = pk2(h[q][1][2] * r, h[q][1][3] * r);
                o1.x = pk2(h[q][2][0] * r, h[q][2][1] * r); o1.y = pk2(h[q][2][2] * r, h[q][2][3] * r); o1.z = pk2(h[q][3][0] * r, h[q][3][1] * r); o1.w = pk2(h[q][3][2] * r, h[q][3][3] * r);
                bf16* xp = xn + (size_t)row * D + 8 * lane;
                *(u32x4v*)xp = o0; *(u32x4v*)(xp + 512) = o1;
            }
        }
    }
}

#else
__device__ __forceinline__ void norm_pass(const Frame& F, const float* hin, const bf16* Y, const float* stat, const float* wpost, float* hout, bf16* xn) {
    const int gw = F.bid * 8 + F.wave, NGW = F.G * 8, lane = F.lane;
    for (int row = gw; row < M; row += NGW) {
        f32x4 h[4];
        const float* hp = hin + (size_t)row * D + 8 * lane;
        h[0] = __builtin_nontemporal_load((const f32x4*)(hp)); h[1] = __builtin_nontemporal_load((const f32x4*)(hp + 4)); h[2] = __builtin_nontemporal_load((const f32x4*)(hp + 512)); h[3] = __builtin_nontemporal_load((const f32x4*)(hp + 516));
        if (Y) {
            const bf16* yp = Y + (size_t)row * D + 8 * lane;
            const u32x4v y0 = *(const u32x4v*)yp, y1 = *(const u32x4v*)(yp + 512);
            float sp = (lane < 16) ? stat[(size_t)row * 16 + lane] : 0.f;
            const float rs = rsqrtf(wave_sum(sp) * (1.f / 1024.f) + EPS);
            const float* wp = wpost + 8 * lane;
            const f32x4 w0 = *(const f32x4*)wp, w1 = *(const f32x4*)(wp + 4), w2 = *(const f32x4*)(wp + 512), w3 = *(const f32x4*)(wp + 516);
            h[0][0] += bflo(y0.x) * rs * w0[0]; h[0][1] += bfhi(y0.x) * rs * w0[1]; h[0][2] += bflo(y0.y) * rs * w0[2]; h[0][3] += bfhi(y0.y) * rs * w0[3];
            h[1][0] += bflo(y0.z) * rs * w1[0]; h[1][1] += bfhi(y0.z) * rs * w1[1]; h[1][2] += bflo(y0.w) * rs * w1[2]; h[1][3] += bfhi(y0.w) * rs * w1[3];
            h[2][0] += bflo(y1.x) * rs * w2[0]; h[2][1] += bfhi(y1.x) * rs * w2[1]; h[2][2] += bflo(y1.y) * rs * w2[2]; h[2][3] += bfhi(y1.y) * rs * w2[3];
            h[3][0] += bflo(y1.z) * rs * w3[0]; h[3][1] += bfhi(y1.z) * rs * w3[1]; h[3][2] += bflo(y1.w) * rs * w3[2]; h[3][3] += bfhi(y1.w) * rs * w3[3];
        }
        if (hout) { float* op = hout + (size_t)row * D + 8 * lane;
            *(f32x4*)op = h[0]; *(f32x4*)(op + 4) = h[1]; *(f32x4*)(op + 512) = h[2]; *(f32x4*)(op + 516) = h[3]; }
        if (xn) {
            float ss = 0.f;
#pragma unroll
            for (int j = 0; j < 4; ++j) ss += (h[j][0] * h[j][0] + h[j][1] * h[j][1]) + (h[j][2] * h[j][2] + h[j][3] * h[j][3]);
            const float r = rsqrtf(wave_sum(ss) * (1.f / 1024.f) + EPS);
            u32x4v o0, o1;
            o0.x = pk2(h[0][0] * r, h[0][1] * r); o0.y = pk2(h[0][2] * r, h[0][3] * r); o0.z = pk2(h[1][0] * r, h[1][1] * r); o0.w = pk2(h[1][2] * r, h[1][3] * r);
            o1.x = pk2(h[2][0] * r, h[2][1] * r); o1.y = pk2(h[2][2] * r, h[2][3] * r); o1.z = pk2(h[3][0] * r, h[3][1] * r); o1.w = pk2(h[3][2] * r, h[3][3] * r);
            bf16* xp = xn + (size_t)row * D + 8 * lane;
            *(u32x4v*)xp = o0; *(u32x4v*)(xp + 512) = o1;
        }
    }
}

#endif
__device__ __forceinline__ int rel_bucket_dev(int rel) {
    const int n = rel < 0 ? -rel : rel; int b;
    if (n < 8) b = n; else { const int lg = 31 - __clz(n * n); int large = 8 + (lg - 6); b = large < 15 ? large : 15; }
    return (rel > 0 ? 16 : 0) + b;
}
__device__ __forceinline__ void prologue_tables(const Frame& F) {
    const int gt = F.bid * 512 + F.tid, NT = F.G * 512;
    float* lbt = (float*)(F.ws + WS_CTL + CTL_LBT);
    float* bt = (float*)(F.ws + WS_CTL + CTL_BT);
    const float* a_lb = F.in[4]; const float* rb = F.in[15];
    for (int i = gt; i < 2048; i += NT) { const int a = i >> 10, col = i & 1023;
        const float x0 = a_lb[col], x1 = a_lb[1024 + col], mx = fmaxf(x0, x1), e0 = __expf(x0 - mx), e1 = __expf(x1 - mx);
        const float s0 = e0 / (e0 + e1), s1 = e1 / (e0 + e1);
        const float lb = (a == 0) ? 0.f : ((s0 + s1) - s0);
        lbt[2 * i] = (lb > 0.f) ? logf(lb) : -INFINITY; lbt[2 * i + 1] = log1pf(-lb); }
    if (F.bid == 0 && F.wave < 2) { const float* lp = F.in[12] + (size_t)F.wave * 256; const int lane = F.lane;
        const float a = wave_sum(lp[lane] * lp[64 + lane]), b2 = wave_sum(lp[128 + lane] * lp[192 + lane]);
        if (lane == 0) ((float*)(F.ws + WS_CTL + CTL_LAM))[F.wave] = __expf(a) - __expf(b2) + lam_init_of(F.wave + 2); }
    for (int i = gt; i < 4096; i += NT) { const int hm = i >> 8, d = i & 255, rel = d - 192;
        bt[i] = (rb[rel_bucket_dev(rel) * 16 + hm] - rb[15 * 16 + hm]) * LOG2E; }
}

typedef short v4i16_t __attribute__((ext_vector_type(4)));
__device__ __forceinline__ s16x4 vtr(LAS const unsigned char* p) { return __builtin_bit_cast(s16x4, __builtin_amdgcn_ds_read_tr16_b64_v4i16((LAS v4i16_t*)p)); }
constexpr int HL_B = 0, HL_SEG = 33792, HL_Q = 35840, HL_VT = 53248  , HL_ST = 73728, HL_P = 108544;
constexpr int BST = 132;
constexpr int QST = 136;
constexpr int VST = 72;
constexpr int HVS = 160;

__device__ __forceinline__ void chunk_cumsum(LAS float* B, LAS float* SEG, int tid) {
    const int seg = tid >> 7, k = tid & 127;
    float v[16];
#pragma unroll
    for (int i = 0; i < 16; ++i) v[i] = B[(seg * 16 + i) * BST + k];
#pragma unroll
    for (int i = 1; i < 16; ++i) v[i] += v[i - 1];
    SEG[seg * 128 + k] = v[15];
    __syncthreads();
    float off = 0.f;
    for (int s2 = 0; s2 < seg; ++s2) off += SEG[s2 * 128 + k];
#pragma unroll
    for (int i = 0; i < 16; ++i) B[(seg * 16 + i) * BST + k] = v[i] + off;
    __syncthreads();
}
__device__ __forceinline__ void load_g_tile(LAS float* B, const float* G, int rowbase, int colbase, int tid) {
#pragma unroll
    for (int i = 0; i < 4; ++i) { const int idx = tid + i * 512, t = idx >> 5, kq = idx & 31;
        *(LAS f32x4*)(B + t * BST + 4 * kq) = *(const f32x4*)(G + (size_t)(rowbase + t) * D + colbase + 4 * kq); }
}
__device__ __forceinline__ void load_v_tile_T(LAS bf16* Vt, const bf16* V, int rowbase, int colbase, int tid) {
#pragma unroll
    for (int i = 0; i < 2; ++i) { const int idx = tid + i * 512, s = idx >> 4, vq = idx & 15;
        const u32x4v w = *(const u32x4v*)(V + (size_t)(rowbase + s) * D + colbase + 8 * vq);
        LAS bf16* p = Vt + (8 * vq) * VST + s;
        p[0 * VST] = (bf16)(w.x & 0xffff); p[1 * VST] = (bf16)(w.x >> 16); p[2 * VST] = (bf16)(w.y & 0xffff); p[3 * VST] = (bf16)(w.y >> 16);
        p[4 * VST] = (bf16)(w.z & 0xffff); p[5 * VST] = (bf16)(w.z >> 16); p[6 * VST] = (bf16)(w.w & 0xffff); p[7 * VST] = (bf16)(w.w >> 16); }
}

__device__ __forceinline__ void hgrn_pass_a(const Frame& F) {
    LAS float* B = (LAS float*)(F.lds3 + HL_B); LAS float* SEG = (LAS float*)(F.lds3 + HL_SEG); LAS bf16* Vt = (LAS bf16*)(F.lds3 + HL_VT); LAS bf16* Ut = (LAS bf16*)(F.lds3 + HL_ST);
    const bf16* G = (const bf16*)(F.ws + WS_G); const bf16* V = (const bf16*)(F.ws + WS_V);
    bf16* Ug = (bf16*)(F.ws + WS_U); float* Dg = (float*)(F.ws + WS_STAT);
    const int tid = F.tid, lane = F.lane, wid = F.wave, r = lane & 31, hh = lane >> 5;
    u32x4v gq[2], vq[2];
#define HA_ISSUE(uu) do { const int h_ = (uu) & 7, c_ = ((uu) >> 3) & 127, b_ = (uu) >> 10, rb_ = b_ * SEQ + c_ * 64, cb_ = h_ * 128; \
        _Pragma("unroll") for (int i = 0; i < 2; ++i) { const int idx = tid + i * 512, s_ = idx >> 4, vq_ = idx & 15; gq[i] = *(const u32x4v*)(G + (size_t)(rb_ + s_) * D + cb_ + 8 * vq_); vq[i] = *(const u32x4v*)(V + (size_t)(rb_ + s_) * D + cb_ + 8 * vq_); } } while (0)
#define HA_WRITE() do { _Pragma("unroll") for (int i = 0; i < 2; ++i) { const int idx = tid + i * 512, s_ = idx >> 4, vq_ = idx & 15; const u32x4v gw = gq[i]; \
            *(LAS f32x4*)(B + s_ * BST + 8 * vq_) = (f32x4){hlo(gw.x), hhi(gw.x), hlo(gw.y), hhi(gw.y)}; *(LAS f32x4*)(B + s_ * BST + 8 * vq_ + 4) = (f32x4){hlo(gw.z), hhi(gw.z), hlo(gw.w), hhi(gw.w)}; \
            *(LAS u32x4v*)(Vt + s_ * HVS + 8 * vq_) = vq[i]; } } while (0)
    if (F.bid < 2048) { HA_ISSUE(F.bid); HA_WRITE(); if (F.bid + F.G < 2048) HA_ISSUE(F.bid + F.G); }
    __syncthreads();
    for (int u = F.bid; u < 2048; u += F.G) {
        const int h = u & 7, c = (u >> 3) & 127, b = u >> 10;
        const int su = (b * 8 + h) * 128 + c;
        chunk_cumsum(B, SEG, tid);
        const int kb = wid & 3, vh = wid >> 2, kcol = 32 * kb + r;
        const float bl = B[63 * BST + kcol];
        f32x16 acc0 = {}, acc1 = {};
#pragma unroll
        for (int s4 = 0; s4 < 4; ++s4) {
            float val[8];
#pragma unroll
            for (int j = 0; j < 8; ++j) { const int s = 16 * s4 + 8 * hh + j; const float bc = B[s * BST + kcol];
                const float bp = (s > 0) ? B[(s > 0 ? s - 1 : 0) * BST + kcol] : 0.f;
                val[j] = (1.f - __expf(bc - bp)) * __expf(bl - bc); }
            u32x4v aw; aw.x = pk2(val[0], val[1]); aw.y = pk2(val[2], val[3]); aw.z = pk2(val[4], val[5]); aw.w = pk2(val[6], val[7]);
            const bf16x8 a = __builtin_bit_cast(bf16x8, aw);
            LAS const unsigned char* vtb = (LAS const unsigned char*)Vt + (16 * s4 + 8 * hh + ((lane & 15) >> 2)) * (HVS * 2) + (64 * vh + 16 * ((lane >> 4) & 1)) * 2 + 8 * (lane & 3);
            const s16x4 l0 = vtr(vtb), h0 = vtr(vtb + 4 * HVS * 2), l1 = vtr(vtb + 64), h1 = vtr(vtb + 4 * HVS * 2 + 64);
            const bf16x8 b0 = __builtin_shufflevector(l0, h0, 0, 1, 2, 3, 4, 5, 6, 7), b1 = __builtin_shufflevector(l1, h1, 0, 1, 2, 3, 4, 5, 6, 7);
            acc0 = MFMA32(a, b0, acc0); acc1 = MFMA32(a, b1, acc1);
        }
#pragma unroll
        for (int g4 = 0; g4 < 4; ++g4) { const int k0 = 32 * kb + 8 * g4 + 4 * hh;
            u32x2v w0, w1; w0.x = pk2(acc0[4 * g4], acc0[4 * g4 + 1]); w0.y = pk2(acc0[4 * g4 + 2], acc0[4 * g4 + 3]);
            w1.x = pk2(acc1[4 * g4], acc1[4 * g4 + 1]); w1.y = pk2(acc1[4 * g4 + 2], acc1[4 * g4 + 3]);
            *(LAS u32x2v*)(Ut + (64 * vh + r) * QST + k0) = w0; *(LAS u32x2v*)(Ut + (64 * vh + 32 + r) * QST + k0) = w1; }
        if (tid < 128) Dg[(size_t)su * 128 + tid] = __expf(B[63 * BST + tid]);
        __syncthreads();
        if (u + F.G < 2048) { HA_WRITE(); if (u + 2 * F.G < 2048) HA_ISSUE(u + 2 * F.G); }
#pragma unroll
        for (int i = 0; i < 4; ++i) { const int idx = tid + i * 512, v = idx >> 4, kq = idx & 15;
            *(u32x4v*)(Ug + (size_t)su * 16384 + v * 128 + 8 * kq) = *(const LAS u32x4v*)(Ut + v * QST + 8 * kq); }
        __syncthreads();
    }
#undef HA_WRITE
}
__device__ __forceinline__ void hgrn_pass_b(const Frame& F, int dry) {
    unsigned* Ug = (unsigned*)(F.ws + WS_U); const float* Dg = (const float*)(F.ws + WS_STAT);
    for (int gid = F.bid * 512 + F.tid; gid < 16 * 8192; gid += F.G * 512) {
        const int chain = gid >> 13, e2 = gid & 8191, k = (2 * e2) & 127;
        unsigned* p = Ug + (size_t)chain * 128 * 8192 + e2; const float* dp = Dg + (size_t)chain * 128 * 128 + k;
        float s0 = 0.f, s1 = 0.f;
        for (int c0 = 0; c0 < 128; c0 += 8) {
            unsigned uu[8]; f32x2 dd[8];
#pragma unroll
            for (int j = 0; j < 8; ++j) { uu[j] = p[(size_t)(c0 + j) * 8192]; dd[j] = *(const f32x2*)(dp + (c0 + j) * 128); }
#pragma unroll
            for (int j = 0; j < 8; ++j) { if (!dry) p[(size_t)(c0 + j) * 8192] = pk2(s0, s1); s0 = dd[j][0] * s0 + bflo(uu[j]); s1 = dd[j][1] * s1 + bfhi(uu[j]); }
        }
    }
}
__device__ __forceinline__ void hgrn_pass_c(const Frame& F, int dry) {
    LAS float* B = (LAS float*)(F.lds3 + HL_B); LAS float* SEG = (LAS float*)(F.lds3 + HL_SEG); LAS bf16* Qs = (LAS bf16*)(F.lds3 + HL_Q); LAS bf16* Vt = (LAS bf16*)(F.lds3 + HL_VT);
    LAS bf16* St = (LAS bf16*)(F.lds3 + HL_ST); LAS bf16* P = (LAS bf16*)(F.lds3 + HL_P);
    const bf16* G = (const bf16*)(F.ws + WS_G); const bf16* V = (const bf16*)(F.ws + WS_V); bf16* Qg = (bf16*)(F.ws + WS_Q); const bf16* Gate = (const bf16*)(F.ws + WS_GATE);
    const bf16* Sg = (const bf16*)(F.ws + WS_U);
    const int tid = F.tid, lane = F.lane, wid = F.wave;
    u32x4v gq[2], vq[2], qq[2], sq[4];
#define HC_ISSUE(uu) do { const int h_ = (uu) & 7, c_ = ((uu) >> 3) & 127, b_ = (uu) >> 10, rb_ = b_ * SEQ + c_ * 64, cb_ = h_ * 128, su_ = (b_ * 8 + h_) * 128 + c_; \
        _Pragma("unroll") for (int i = 0; i < 2; ++i) { const int idx = tid + i * 512, s_ = idx >> 4, c16 = idx & 15; gq[i] = *(const u32x4v*)(G + (size_t)(rb_ + s_) * D + cb_ + 8 * c16); vq[i] = *(const u32x4v*)(V + (size_t)(rb_ + s_) * D + cb_ + 8 * c16); \
            qq[i] = *(const u32x4v*)(Qg + (size_t)(rb_ + s_) * D + cb_ + 8 * c16); } \
        _Pragma("unroll") for (int i = 0; i < 4; ++i) { const int idx = tid + i * 512, v_ = idx >> 4, kq = idx & 15; sq[i] = *(const u32x4v*)(Sg + (size_t)su_ * 16384 + v_ * 128 + 8 * kq); } } while (0)
#define HC_WRITE_A() do { _Pragma("unroll") for (int i = 0; i < 2; ++i) { const int idx = tid + i * 512, s_ = idx >> 4, c16 = idx & 15; const u32x4v gw = gq[i]; \
            *(LAS f32x4*)(B + s_ * BST + 8 * c16) = (f32x4){hlo(gw.x), hhi(gw.x), hlo(gw.y), hhi(gw.y)}; *(LAS f32x4*)(B + s_ * BST + 8 * c16 + 4) = (f32x4){hlo(gw.z), hhi(gw.z), hlo(gw.w), hhi(gw.w)}; \
            *(LAS u32x4v*)(Vt + s_ * HVS + 8 * c16) = vq[i]; *(LAS u32x4v*)(Qs + s_ * QST + 8 * c16) = qq[i]; } \
        { unsigned zz = 0u; asm volatile("" : "+v"(zz)); for (int idx = tid; idx < 576; idx += 512) *(LAS u32x4v*)(P + idx * 8) = (u32x4v){zz, zz, zz, zz}; } } while (0)
#define HC_WRITE_S() do { _Pragma("unroll") for (int i = 0; i < 4; ++i) { const int idx = tid + i * 512, v_ = idx >> 4, kq = idx & 15; *(LAS u32x4v*)(St + v_ * QST + 8 * kq) = sq[i]; } } while (0)
    if (F.bid < 2048) { HC_ISSUE(F.bid); HC_WRITE_A(); HC_WRITE_S(); if (F.bid + F.G < 2048) HC_ISSUE(F.bid + F.G); }
    __syncthreads();
    for (int u = F.bid; u < 2048; u += F.G) {
        const int h = u & 7, c = (u >> 3) & 127, b = u >> 10;
        const int rowbase = b * SEQ + c * 64, colbase = h * 128;
        const size_t goff = (size_t)(rowbase + (tid >> 3)) * D + colbase + 16 * (tid & 7);
        const u32x4v g0 = *(const u32x4v*)(Gate + goff), g1 = *(const u32x4v*)(Gate + goff + 8);
        chunk_cumsum(B, SEG, tid);
        for (int blk = wid; blk < 10; blk += 8) {
            int T, Sb; if (blk < 4) { T = blk; Sb = 0; } else if (blk < 7) { T = blk - 3; Sb = 1; } else if (blk < 9) { T = blk - 5; Sb = 2; } else { T = 3; Sb = 3; }
            const int r16 = lane & 15, gq = lane >> 4, t = 16 * T + r16, s = 16 * Sb + r16, sp = s > 0 ? s - 1 : 0;
            f32x4 acc = {0.f, 0.f, 0.f, 0.f};
#pragma unroll
            for (int ks = 0; ks < 4; ++ks) { const int k0 = 32 * ks + 8 * gq;
                const f32x4 br0 = *(const LAS f32x4*)(B + (16 * Sb + 15) * BST + k0), br1 = *(const LAS f32x4*)(B + (16 * Sb + 15) * BST + k0 + 4);
                const f32x4 bt0 = *(const LAS f32x4*)(B + t * BST + k0), bt1 = *(const LAS f32x4*)(B + t * BST + k0 + 4);
                const f32x4 bs0 = *(const LAS f32x4*)(B + s * BST + k0), bs1 = *(const LAS f32x4*)(B + s * BST + k0 + 4);
                f32x4 bp0 = *(const LAS f32x4*)(B + sp * BST + k0), bp1 = *(const LAS f32x4*)(B + sp * BST + k0 + 4);
                if (s == 0) { bp0 = (f32x4){0.f, 0.f, 0.f, 0.f}; bp1 = bp0; }
                const u32x4v qw = *(const LAS u32x4v*)(Qs + t * QST + k0);
                float qa[8] = {bflo(qw.x), bfhi(qw.x), bflo(qw.y), bfhi(qw.y), bflo(qw.z), bfhi(qw.z), bflo(qw.w), bfhi(qw.w)};
                float av[8], bv[8];
#pragma unroll
                for (int e = 0; e < 4; ++e) {
                    av[e] = qa[e] * __expf(bt0[e] - br0[e]); av[4 + e] = qa[4 + e] * __expf(bt1[e] - br1[e]);
                    bv[e] = (1.f - __expf(bs0[e] - bp0[e])) * __expf(br0[e] - bs0[e]); bv[4 + e] = (1.f - __expf(bs1[e] - bp1[e])) * __expf(br1[e] - bs1[e]); }
                u32x4v aw, bw; aw.x = pk2(av[0], av[1]); aw.y = pk2(av[2], av[3]); aw.z = pk2(av[4], av[5]); aw.w = pk2(av[6], av[7]);
                bw.x = pk2(bv[0], bv[1]); bw.y = pk2(bv[2], bv[3]); bw.z = pk2(bv[4], bv[5]); bw.w = pk2(bv[6], bv[7]);
                acc = MFMA16(__builtin_bit_cast(bf16x8, aw), __builtin_bit_cast(bf16x8, bw), acc);
            }
#pragma unroll
            for (int i = 0; i < 4; ++i) { float v = acc[i]; if (T == Sb && r16 > 4 * gq + i) v = 0.f;
                P[(16 * T + 4 * gq + i) * VST + 16 * Sb + r16] = (bf16)(pk2(v, 0.f) & 0xffff); }
        }
        const int r = lane & 31, hh = lane >> 5, tb = wid & 1, vb = wid >> 1, t32 = 32 * tb + r;
        f32x16 o = {};
#pragma unroll
        for (int ks = 0; ks < 8; ++ks) { const int k0 = 16 * ks + 8 * hh;
            const f32x4 b0 = *(const LAS f32x4*)(B + t32 * BST + k0), b1 = *(const LAS f32x4*)(B + t32 * BST + k0 + 4);
            const u32x4v qw = *(const LAS u32x4v*)(Qs + t32 * QST + k0);
            u32x4v aw;
            aw.x = pk2(bflo(qw.x) * __expf(b0[0]), bfhi(qw.x) * __expf(b0[1])); aw.y = pk2(bflo(qw.y) * __expf(b0[2]), bfhi(qw.y) * __expf(b0[3]));
            aw.z = pk2(bflo(qw.z) * __expf(b1[0]), bfhi(qw.z) * __expf(b1[1])); aw.w = pk2(bflo(qw.w) * __expf(b1[2]), bfhi(qw.w) * __expf(b1[3]));
            const bf16x8 bfr = *(const LAS bf16x8*)(St + (32 * vb + r) * QST + k0);
            o = MFMA32(__builtin_bit_cast(bf16x8, aw), bfr, o);
        }
        __syncthreads();
#pragma unroll
        for (int ss = 0; ss < 4; ++ss) {
            const bf16x8 a = *(const LAS bf16x8*)(P + t32 * VST + 16 * ss + 8 * hh);
            LAS const unsigned char* vtb = (LAS const unsigned char*)Vt + (16 * ss + 8 * hh + ((lane & 15) >> 2)) * (HVS * 2) + (32 * vb + 16 * ((lane >> 4) & 1)) * 2 + 8 * (lane & 3);
            const s16x4 l0 = vtr(vtb), h0 = vtr(vtb + 4 * HVS * 2);
            const bf16x8 bfr = __builtin_shufflevector(l0, h0, 0, 1, 2, 3, 4, 5, 6, 7);
            o = MFMA32(a, bfr, o);
        }
        LAS float* OT = (LAS float*)(F.lds3 + HL_ST);
#pragma unroll
        for (int i = 0; i < 16; ++i) OT[(32 * tb + crow(i, hh)) * BST + 32 * vb + r] = o[i];
        __syncthreads();
        if (u + F.G < 2048) HC_WRITE_A();
        {
            const int t = tid >> 3, vq = tid & 7;
            f32x4 x[4]; float ss = 0.f;
#pragma unroll
            for (int j = 0; j < 4; ++j) { x[j] = *(const LAS f32x4*)(OT + t * BST + 16 * vq + 4 * j); ss += (x[j][0] * x[j][0] + x[j][1] * x[j][1]) + (x[j][2] * x[j][2] + x[j][3] * x[j][3]); }
            ss += __shfl_xor(ss, 1); ss += __shfl_xor(ss, 2); ss += __shfl_xor(ss, 4);
            const float rs = rsqrtf(ss * (1.f / 128.f) + EPS);
            u32x4v o0, o1;
            o0.x = pk2(x[0][0] * rs * bflo(g0.x), x[0][1] * rs * bfhi(g0.x)); o0.y = pk2(x[0][2] * rs * bflo(g0.y), x[0][3] * rs * bfhi(g0.y));
            o0.z = pk2(x[1][0] * rs * bflo(g0.z), x[1][1] * rs * bfhi(g0.z)); o0.w = pk2(x[1][2] * rs * bflo(g0.w), x[1][3] * rs * bfhi(g0.w));
            o1.x = pk2(x[2][0] * rs * bflo(g1.x), x[2][1] * rs * bfhi(g1.x)); o1.y = pk2(x[2][2] * rs * bflo(g1.y), x[2][3] * rs * bfhi(g1.y));
            o1.z = pk2(x[3][0] * rs * bflo(g1.z), x[3][1] * rs * bfhi(g1.z)); o1.w = pk2(x[3][2] * rs * bflo(g1.w), x[3][3] * rs * bfhi(g1.w));
            if (!dry) { *(u32x4v*)(Qg + goff) = o0; *(u32x4v*)(Qg + goff + 8) = o1; }
        }
        __syncthreads();
        if (u + F.G < 2048) { HC_WRITE_S(); if (u + 2 * F.G < 2048) HC_ISSUE(u + 2 * F.G); }
    }
#undef HC_WRITE_A
#undef HC_WRITE_S
}

constexpr int AL_K0 = 0, AL_K1 = 17408, AL_V0 = 34816  , AL_BT = 96256  ;
constexpr int VSTR = 160;
constexpr int KST = 136;

__device__ __forceinline__ void attn_phase(const Frame& F, int L, int dry, int knob) {
    const bf16* Qg = (const bf16*)(F.ws + WS_Q); const bf16* Kg = (const bf16*)(F.ws + WS_UX); const bf16* Vg = (const bf16*)(F.ws + WS_VB); bf16* Og = (bf16*)(F.ws + WS_Q);
    const float* btg = (const float*)(F.ws + WS_CTL + CTL_BT);
    const int tid = F.tid, lane = F.lane, wid = F.wave, r = lane & 31, hh = lane >> 5;
    const int m = wid & 1, qs = wid >> 1;
    LAS float* BT = (LAS float*)(F.lds3 + AL_BT);
    const float lam = ((const float*)(F.ws + WS_CTL + CTL_LAM))[L - 2];
    const int NU = 1024;
    const int vcu = ((F.G & 7) == 0) ? (F.bid & 7) * (F.G >> 3) + (F.bid >> 3) : F.bid;
    for (int Lu = vcu; Lu < NU; Lu += F.G) {
        const int rnd = Lu >> 8, j = Lu & 255, bh = j >> 4, jj = j & 15;
        const int qb = (rnd == 0) ? 63 - jj : (rnd == 1) ? 32 + jj : (rnd == 2) ? 31 - jj : jj;
        const int b = bh >> 3, h = bh & 7;
        const int NT = 2 * qb + 2, qc = 2 * qb + (qs >> 1), my_nt = qc + 1;
        const size_t rowb = (size_t)b * SEQ;
        BT[tid] = btg[h * 512 + tid];
        const int q0 = qb * 128 + qs * 32;
        bf16x8 qf[4];
#pragma unroll
        for (int ks = 0; ks < 4; ++ks) qf[ks] = *(const bf16x8*)(Qg + (rowb + q0 + r) * D + h * 128 + m * 64 + 16 * ks + 8 * hh);
        f32x16 O[4];
#pragma unroll
        for (int vt = 0; vt < 4; ++vt) O[vt] = (f32x16){};
        float mref = 0.f, lrun = 0.f; f32x16 negm = (f32x16){};
        bf16x8 pf[4];
        const int lag = wid >> 2;
        const int i16 = lane & 15, q4 = i16 >> 2, p4 = i16 & 3, blk = (lane >> 4) & 1;
        const int vlane_off = (4 * hh + q4) * (VSTR * 2) + 32 * blk + 8 * p4;
#define PVD 3
#define PV_RD(i) do { fl[i] = vtr(vbase + (16 * ((i) & 3)) * (VSTR * 2) + 64 * ((i) >> 2)); fh[i] = vtr(vbase + (16 * ((i) & 3) + 8) * (VSTR * 2) + 64 * ((i) >> 2)); } while (0)
#define PV_TILE(slot) do { LAS const unsigned char* vbase = F.lds3 + AL_V0 + (slot) * 20480 + vlane_off; s16x4 fl[16], fh[16]; \
            _Pragma("unroll") for (int i = 0; i < PVD; ++i) PV_RD(i); \
            _Pragma("unroll") for (int i = 0; i < 16; ++i) { if (i + PVD < 16) PV_RD(i + PVD); \
                const bf16x8 vf = __builtin_shufflevector(fl[i], fh[i], 0, 1, 2, 3, 4, 5, 6, 7); __builtin_amdgcn_s_setprio(1); O[i >> 2] = MFMA32(vf, pf[i & 3], O[i >> 2]); __builtin_amdgcn_s_setprio(0); } } while (0)
        u32x4v kr[2], vr[2];
        const int ls = tid >> 4, lc = tid & 15;
#define LOAD_TILE(kt) do { _Pragma("unroll") for (int i = 0; i < 2; ++i) { const size_t off = (rowb + 64 * (kt) + ls + 32 * i) * D + h * 128 + 8 * lc; \
            kr[i] = *(const u32x4v*)(Kg + off); vr[i] = *(const u32x4v*)(Vg + off); } } while (0)
#define ST_WRITE(kb_, vb_) do { _Pragma("unroll") for (int i = 0; i < 2; ++i) { *(LAS u32x4v*)((kb_) + ((ls + 32 * i) * KST + 8 * lc) * 2) = kr[i]; *(LAS u32x4v*)((vb_) + ((ls + 32 * i) * VSTR + 8 * lc) * 2) = vr[i]; } } while (0)
        LOAD_TILE(0);
        ST_WRITE(F.lds3 + AL_K0, F.lds3 + AL_V0);
        LOAD_TILE(1);
        const int qoff = (qs & 1) * 32 + r;
        int vs = 0, vp = 2;
        for (int kt = 0; kt < NT; ++kt) {
            LAS unsigned char* Kb = F.lds3 + ((kt & 1) ? AL_K1 : AL_K0);
            __syncthreads();
            if (kt + 1 < NT) { const int vn = (vs == 2) ? 0 : vs + 1;
                ST_WRITE(F.lds3 + ((kt & 1) ? AL_K0 : AL_K1), F.lds3 + AL_V0 + vn * 20480);
                if (kt + 2 < NT) LOAD_TILE(kt + 2); }
            if (lag && kt > 0) PV_TILE(vp);
            if (kt < my_nt) {
                const LAS bf16* Kt = (const LAS bf16*)Kb;
                f32x16 S0, S1;
                {
                    const bf16x8 a0 = *(const LAS bf16x8*)(Kt + r * KST + m * 64 + 8 * hh);
                    const bf16x8 a1 = *(const LAS bf16x8*)(Kt + (32 + r) * KST + m * 64 + 8 * hh);
                    S0 = MFMA32(a0, qf[0], negm); S1 = MFMA32(a1, qf[0], negm);
                }
#pragma unroll
                for (int ks = 1; ks < 4; ++ks) {
                    const bf16x8 a0 = *(const LAS bf16x8*)(Kt + r * KST + m * 64 + 16 * ks + 8 * hh);
                    const bf16x8 a1 = *(const LAS bf16x8*)(Kt + (32 + r) * KST + m * 64 + 16 * ks + 8 * hh);
                    S0 = MFMA32(a0, qf[ks], S0); S1 = MFMA32(a1, qf[ks], S1);
                }
                const int delta = qc - kt;
                if (delta <= 2) {
                    const LAS float* bp = BT + m * 256 + (192 - 64 * delta - qoff);
#pragma unroll
                    for (int i = 0; i < 16; ++i) { S0[i] += bp[crow(i, hh)]; S1[i] += bp[32 + crow(i, hh)]; }
                }
                float mx = __builtin_fmaxf(__builtin_fmaxf(S0[0], S1[0]), S0[1]), mx2 = __builtin_fmaxf(__builtin_fmaxf(S1[1], S0[2]), S1[2]);
#pragma unroll
                for (int i = 3; i < 15; i += 2) { mx = __builtin_fmaxf(__builtin_fmaxf(mx, S0[i]), S1[i]); mx2 = __builtin_fmaxf(__builtin_fmaxf(mx2, S0[i + 1]), S1[i + 1]); }
                mx = __builtin_fmaxf(__builtin_fmaxf(mx, S0[15]), S1[15]); mx = __builtin_fmaxf(mx, mx2);
                { auto rr = __builtin_amdgcn_permlane32_swap(__float_as_uint(mx), __float_as_uint(mx), false, false); mx = __builtin_fmaxf(__uint_as_float(rr[0]), __uint_as_float(rr[1])); }
                if (kt == 0 || __any(mx > 8.f)) {
                    const float dl = (kt == 0) ? mx : fmaxf(mx, 0.f);
                    mref += dl;
                    const float f = __builtin_amdgcn_exp2f(-dl);
                    lrun *= f;
#pragma unroll
                    for (int i = 0; i < 16; ++i) { S0[i] -= dl; S1[i] -= dl; negm[i] = -mref; }
#pragma unroll
                    for (int vt = 0; vt < 4; ++vt)
#pragma unroll
                        for (int i = 0; i < 16; ++i) O[vt][i] *= f;
                }
                f32x2 ls2 = {0.f, 0.f};
#pragma unroll
                for (int i = 0; i < 16; i += 2) {
                    S0[i] = __builtin_amdgcn_exp2f(S0[i]); S0[i + 1] = __builtin_amdgcn_exp2f(S0[i + 1]);
                    S1[i] = __builtin_amdgcn_exp2f(S1[i]); S1[i + 1] = __builtin_amdgcn_exp2f(S1[i + 1]);
                    ls2 += (f32x2){S0[i], S0[i + 1]}; ls2 += (f32x2){S1[i], S1[i + 1]}; }
                lrun += ls2[0] + ls2[1];
                { u32x4v w;
                  w.x = pk2(S0[0], S0[1]); w.y = pk2(S0[2], S0[3]); w.z = pk2(S0[4], S0[5]); w.w = pk2(S0[6], S0[7]); pf[0] = __builtin_bit_cast(bf16x8, w);
                  w.x = pk2(S0[8], S0[9]); w.y = pk2(S0[10], S0[11]); w.z = pk2(S0[12], S0[13]); w.w = pk2(S0[14], S0[15]); pf[1] = __builtin_bit_cast(bf16x8, w);
                  w.x = pk2(S1[0], S1[1]); w.y = pk2(S1[2], S1[3]); w.z = pk2(S1[4], S1[5]); w.w = pk2(S1[6], S1[7]); pf[2] = __builtin_bit_cast(bf16x8, w);
                  w.x = pk2(S1[8], S1[9]); w.y = pk2(S1[10], S1[11]); w.z = pk2(S1[12], S1[13]); w.w = pk2(S1[14], S1[15]); pf[3] = __builtin_bit_cast(bf16x8, w); }
                if (!lag) PV_TILE(vs);
            }
            vp = vs; vs = (vs == 2) ? 0 : vs + 1;
        }
        if (lag) PV_TILE(vp);
#undef PV_TILE
#undef PV_RD
#undef PVD
#undef LOAD_TILE
#undef ST_WRITE
        __syncthreads();
        const float ltot = lrun + __shfl_xor(lrun, 32), inv = 1.f / ltot;
        LAS float* XCH = (LAS float*)(F.lds3) + qs * 4096;
        if (m == 1) { const float sc = -lam * inv;
#pragma unroll
            for (int vt = 0; vt < 4; ++vt)
#pragma unroll
                for (int i = 0; i < 16; ++i) XCH[(vt * 16 + i) * 64 + lane] = O[vt][i] * sc; }
        __syncthreads();
        if (m == 0) {
            float ss = 0.f;
#pragma unroll
            for (int vt = 0; vt < 4; ++vt)
#pragma unroll
                for (int i = 0; i < 16; ++i) { const float v = O[vt][i] * inv + XCH[(vt * 16 + i) * 64 + lane]; O[vt][i] = v; ss += v * v; }
            ss += __shfl_xor(ss, 32);
            const float rs = rsqrtf(ss * (1.f / 128.f) + EPS);
            LAS bf16* STG = (LAS bf16*)(F.lds3 + qs * 16384);
#pragma unroll
            for (int vt = 0; vt < 4; ++vt)
#pragma unroll
                for (int g4 = 0; g4 < 4; ++g4) { u32x2v w; w.x = pk2(O[vt][4 * g4] * rs, O[vt][4 * g4 + 1] * rs); w.y = pk2(O[vt][4 * g4 + 2] * rs, O[vt][4 * g4 + 3] * rs);
                    *(LAS u32x2v*)(STG + r * KST + 32 * vt + 8 * g4 + 4 * hh) = w; }
            __builtin_amdgcn_s_waitcnt(0xc07f); asm volatile("" ::: "memory");
#pragma unroll
            for (int i2 = 0; i2 < 8; ++i2) { const int idx = lane + 64 * i2, row = idx >> 4, cq = idx & 15;
                if (!dry) *(u32x4v*)(Og + (rowb + q0 + row) * D + h * 128 + 8 * cq) = *(const LAS u32x4v*)(STG + row * KST + 8 * cq); }
        }
        __syncthreads();
    }
}

#define XB_TMO      128
#define XB_XCNT(j)  (256  + 64 * (j))
#define XB_XSUB(j)  (1280 + 64 * (j))
#define XB_XGEN(j)  (2304 + 64 * (j))
#define XB_TOP      3328
#define XB_TOPGEN   3392
#define XCD_BAR_WORDS 3456
#define XB_SPIN_CAP (1u << 18)

__device__ __forceinline__ unsigned xb_ld(unsigned* p)              { return __hip_atomic_load(p, __ATOMIC_RELAXED, __HIP_MEMORY_SCOPE_AGENT); }
__device__ __forceinline__ unsigned xb_add(unsigned* p, unsigned v) { return __hip_atomic_fetch_add(p, v, __ATOMIC_RELAXED, __HIP_MEMORY_SCOPE_AGENT); }
__device__ __forceinline__ unsigned xb_xcc_id() { return (unsigned)__builtin_amdgcn_s_getreg((3 << 11) | 20) & 0xFu; }
#define XB_SPIN(cond, bar) do { unsigned _sp = 0; while (cond) { __builtin_amdgcn_s_sleep(1); \
    if ((++_sp & 255u) == 0u) { if (xb_ld(&(bar)[XB_TMO])) break; if (_sp > XB_SPIN_CAP) { atomicAdd(&(bar)[XB_TMO], 1u); break; } } } } while (0)

struct XcdBarrier {
    unsigned* bar; unsigned x;
    volatile LAS unsigned* st;
};

__device__ __forceinline__ XcdBarrier xcd_barrier_post(unsigned* bar, volatile LAS unsigned* st) {
    XcdBarrier b; b.bar = bar; b.x = xb_xcc_id(); b.st = st;
    if (threadIdx.x == 0) (void)xb_add(&bar[XB_XCNT(b.x)], 1u);
    return b;
}
__device__ __forceinline__ void xcd_barrier_complete(unsigned* bar, unsigned x, unsigned& nloc, unsigned& nx) {
    const unsigned G = gridDim.x * gridDim.y * gridDim.z;
    unsigned sum, cnt, mine, sp = 0u;
    for (;;) {
        sum = 0u; cnt = 0u; mine = 0u;
#pragma unroll
        for (unsigned j = 0; j < 16; ++j) { const unsigned c = xb_ld(&bar[XB_XCNT(j)]); sum += c; cnt += (c > 0u) ? 1u : 0u; mine = (j == x) ? c : mine; }
        if (sum == G) break;
        __builtin_amdgcn_s_sleep(1);
        if ((++sp & 255u) == 0u) { if (xb_ld(&bar[XB_TMO])) break; if (sp > XB_SPIN_CAP) { atomicAdd(&bar[XB_TMO], 1u); break; } }
    }
    nloc = mine > 0u ? mine : 1u; nx = cnt > 0u ? cnt : 1u;
}

__device__ __forceinline__ void xcd_barrier(const XcdBarrier& b) {
    asm volatile("s_waitcnt vmcnt(0)" ::: "memory");
    __syncthreads();
    if (threadIdx.x == 0) {
        unsigned* bar = b.bar;
        __builtin_amdgcn_s_waitcnt(0);
        unsigned nloc = b.st[0], nx = b.st[1];
        if (nloc == 0u) { xcd_barrier_complete(bar, b.x, nloc, nx); b.st[0] = nloc; b.st[1] = nx; }
        const unsigned old = xb_add(&bar[XB_XSUB(b.x)], 1u);
        const unsigned gen = old / nloc;
        if (old + 1u == (gen + 1u) * nloc) {
            __builtin_amdgcn_fence(__ATOMIC_RELEASE, "agent");
            asm volatile("s_waitcnt vmcnt(0)" ::: "memory");
            const unsigned og = xb_add(&bar[XB_TOP], 1u);
            const unsigned tg = og / nx;
            if (og + 1u == (tg + 1u) * nx) xb_add(&bar[XB_TOPGEN], 1u);
            else XB_SPIN(xb_ld(&bar[XB_TOPGEN]) == tg, bar);
            __builtin_amdgcn_fence(__ATOMIC_ACQUIRE, "agent");
            xb_add(&bar[XB_XGEN(b.x)], 1u);
            asm volatile("s_waitcnt vmcnt(0)" ::: "memory");
        } else {
            XB_SPIN(xb_ld(&bar[XB_XGEN(b.x)]) == gen, bar);
            __builtin_amdgcn_fence(__ATOMIC_ACQUIRE, "agent");
            asm volatile("s_waitcnt vmcnt(0)" ::: "memory");
        }
    }
    __syncthreads();
}

__global__ void __launch_bounds__(512, 2) yoco_fwd(Args args) {
    extern __shared__ __attribute__((aligned(16))) unsigned char lds[];
    volatile LAS unsigned* bst = (volatile LAS unsigned*)((LAS unsigned char*)lds + 131072);
    if (threadIdx.x < 2) bst[threadIdx.x] = 0u;
    __syncthreads();
    if (args.hi - args.lo > 1) (void)xcd_barrier_post((unsigned*)(args.ws + WS_CTL + CTL_BAR), bst);
    for (int ph = args.lo; ph < args.hi; ++ph) {
        int tid_ = threadIdx.x; asm volatile("" : "+v"(tid_));
        size_t zoff_ = 0; asm volatile("" : "+s"(zoff_)); unsigned char* ws = args.ws + zoff_;
        int z_ = 0; asm volatile("" : "+s"(z_));
        Frame F;
        F.lds = lds; F.lds3 = (LAS unsigned char*)lds;
        F.tid = tid_; F.lane = F.tid & 63; F.wave = __builtin_amdgcn_readfirstlane(F.tid >> 6);
        F.G = gridDim.x; F.bid = blockIdx.x; F.in = args.in + z_; F.H = (args.out + zoff_); F.ws = ws;
        bf16* WA = (bf16*)(ws + WS_W + W_A); bf16* WO = (bf16*)(ws + WS_W + W_O); bf16* WU = (bf16*)(ws + WS_W + W_U); bf16* WD = (bf16*)(ws + WS_W + W_D);
        bf16* XN = (bf16*)(ws + WS_XN); bf16* QB = (bf16*)(ws + WS_Q); bf16* HID = (bf16*)(ws + WS_HID);
        float* STAT = (float*)(ws + WS_STAT);
        const int kind = args.kind[ph], L = args.layer[ph] & 15, dry = args.layer[ph] >> 7, knob = (args.layer[ph] >> 4) & 7;
        switch (kind) {
        case K_PRO: {
            prologue_tables(F);
            norm_pass(F, F.in[0], nullptr, nullptr, nullptr, nullptr, XN);
        } break;
#ifndef SKIP_WIN
        case K_WIN: {
            pg8::Gemm g{XN, WA, M, 4096, D}; pg8::StaticOrder S; S.init(M, 4096, F.G, F.bid);
            EpiWin E{ws, (const float*)(ws + WS_CTL + CTL_LBT) + (size_t)L * 2048};
            pg8::gemm_phase<EpiWin, pg8::StaticOrder, true, true>(F.lds3, g, S, E, F.tid);
        } break;
#endif
        #ifndef SKIP_HA
        case K_HA: hgrn_pass_a(F); break;
#endif
        #ifndef SKIP_HB
        case K_HB: hgrn_pass_b(F, dry); break;
#endif
        #ifndef SKIP_HC
        case K_HC: hgrn_pass_c(F, dry); break;
#endif
#ifndef SKIP_UP
        case K_UP: {
            pg8::Gemm g{XN, WU, M, FF, D}; pg8::StaticOrder S; S.init(M, FF, F.G, F.bid);
            EpiRelu2 E{HID};
            pg8::gemm_phase<EpiRelu2, pg8::StaticOrder, true, true>(F.lds3, g, S, E, F.tid);
        } break;
#endif
#ifndef SKIP_KVQ
        case K_KVQ: case K_QG: {
            const int N = (kind == K_KVQ) ? 3072 : 1024;
            pg8::Gemm g{XN, WA, M, N, D}; pg8::StaticOrder S; S.init(M, N, F.G, F.bid);
            EpiSplit E{ws, kind == K_KVQ ? 1 : 0};
            pg8::gemm_phase<EpiSplit, pg8::StaticOrder, true, true>(F.lds3, g, S, E, F.tid);
        } break;
#endif
        #ifndef SKIP_ATT
        case K_ATT: attn_phase(F, L, dry, knob); break;
#endif
        case K_YOUTF: case K_DOWNF: {
            const int isd = (kind == K_DOWNF) ? 1 : 0, use = (L * 2 + isd) * 2;
            const float* wpost = isd ? F.in[17] + L * D : ((L < 2) ? F.in[2] + L * D : F.in[10] + (L - 2) * D);
            float* Hp = args.out + zoff_;
            const float* hin = (L == 0 && !isd) ? F.in[0] : Hp;
            unsigned* cntb = (unsigned*)(ws + WS_CTL + CTL_CNT);
            EpiNormF E{hin, Hp, (isd && L == 3) ? nullptr : XN, wpost,
                       RowStatX{(float*)(ws + WS_STAT), cntb + (size_t)use * 4096}, RowStatX{(float*)(ws + WS_STAT + 262144), cntb + (size_t)(use + 1) * 4096}};
            pg8::StaticOrder S; S.init(M, D, F.G, F.bid);
            if (isd) { pg8::Gemm g{HID, WD, M, D, FF}; pg8::gemm_phase<EpiNormF, pg8::StaticOrder, false, true>(F.lds3, g, S, E, F.tid); }
            else { pg8::Gemm g{QB, WO, M, D, D}; pg8::gemm_phase<EpiNormF, pg8::StaticOrder, false, true>(F.lds3, g, S, E, F.tid); }
        } break;
        default: break;
        }
        { const int cvb = args.cv[ph]; if (cvb) { __syncthreads(); convert_layer(F, cvb >> 4, cvb & 15); } }
        if (ph + 1 < args.hi) {
            if (args.hi < 0) { __syncthreads(); cg::this_grid().sync(); }
            XcdBarrier bar; bar.bar = (unsigned*)(ws + WS_CTL + CTL_BAR); bar.x = xb_xcc_id(); bar.st = bst; xcd_barrier(bar);
        }
    }
}

#ifndef N_LAUNCH_MODE
#define N_LAUNCH_MODE 0
#endif
extern "C" void kernel_launch(void* const* d_in, const int* in_sizes, int n_in, void* d_out, int out_size, void* d_ws, size_t ws_size, hipStream_t stream) {
    static int grid = 0;
    if (grid == 0) {
        int dev = 0, cus = 0, per_cu = 0;
        (void)hipGetDevice(&dev); (void)hipDeviceGetAttribute(&cus, hipDeviceAttributeMultiprocessorCount, dev);
        (void)hipFuncSetAttribute((const void*)yoco_fwd, hipFuncAttributeMaxDynamicSharedMemorySize, LDS_TOTAL);
        (void)hipOccupancyMaxActiveBlocksPerMultiprocessor(&per_cu, (const void*)yoco_fwd, 512, LDS_TOTAL);
        (void)hipGetLastError();
        if (per_cu < 1) per_cu = 1;
        grid = cus > 0 ? cus : 256;
        if (ws_size < 252 * MiB) fprintf(stderr, "kernel_launch: workspace too small (%zu)\n", ws_size);
    }
    (void)hipMemsetAsync((unsigned char*)d_ws + WS_CTL + CTL_BAR, 0, CTL_ZERO_END - CTL_BAR, stream);
    Args a{};
    for (int i = 0; i < 20; ++i) a.in[i] = (const float*)d_in[i];
    a.out = (float*)d_out; a.ws = (unsigned char*)d_ws;
    int n = 0;
#ifndef PROBE_MASK
#define PROBE_MASK 0
#endif
#ifndef PROBE_KNOB
#define PROBE_KNOB 0
#endif
    auto add = [&](int k, int l, int cvb = 0) { if ((PROBE_MASK >> k) & 1) { a.kind[n] = (unsigned char)k; a.layer[n] = (unsigned char)(l | 128 | (PROBE_KNOB << 4)); a.cv[n] = 0; ++n; }
                                   a.kind[n] = (unsigned char)k; a.layer[n] = (unsigned char)l; a.cv[n] = (unsigned char)cvb; ++n; };
    add(K_PRO, 0, 15);
    {
        for (int L = 0; L < 2; ++L) { add(K_WIN, L, L == 1 ? ((1 << 4) | 8) : 0); add(K_HA, L); add(K_HB, L); add(K_HC, L); add(K_YOUTF, L); add(K_UP, L); add(K_DOWNF, L, ((L + 1) << 4) | 7); }
        add(K_KVQ, 2, (2 << 4) | 8);
        for (int L = 2; L < 4; ++L) { if (L == 3) add(K_QG, L, (3 << 4) | 8); add(K_ATT, L); add(K_YOUTF, L); add(K_UP, L); add(K_DOWNF, L, L < 3 ? (((L + 1) << 4) | 7) : 0); }
    }
#if N_LAUNCH_MODE == 0
    a.lo = 0; a.hi = n;
    void* kargs[] = {&a};
    hipError_t e = hipLaunchCooperativeKernel((const void*)yoco_fwd, dim3(grid), dim3(512), kargs, LDS_TOTAL, stream);
    if (e != hipSuccess) fprintf(stderr, "cooperative launch failed: %s (grid %d)\n", hipGetErrorString(e), grid);
#else
    for (int p = 0; p < n; ++p) { a.lo = p; a.hi = p + 1; hipLaunchKernelGGL(yoco_fwd, dim3(grid), dim3(512), LDS_TOTAL, stream, a); }
#endif
}
```

```cpp
#include <hip/hip_runtime.h>
#include <hip/hip_cooperative_groups.h>
#include <hip/hip_bf16.h>
#include <cstdio>
#include <cstdint>
#include <cmath>
namespace cg = cooperative_groups;
#define N_LAUNCH_MODE 0
namespace pg8 {
#define PG8_LAS __attribute__((address_space(3)))
typedef unsigned short bf16_t;
typedef short bf16x8 __attribute__((ext_vector_type(8)));
typedef float f32x4 __attribute__((ext_vector_type(4)));
typedef unsigned u32x4 __attribute__((ext_vector_type(4)));
constexpr int BM = 256, BK = 64, HALF = 128, HTB = HALF * BK * 2  , STAGE_BYTES = 8 * HTB, NXCD = 8, WGM = 8;

__host__ __device__ __forceinline__ int lds_byte(int r, int c) { const int st = (r >> 4) * 2 + (c >> 5), rr = r & 15, cc = c & 31, ob = rr * 64 + cc * 2; return st * 1024 + (ob ^ (((ob >> 9) & 1) << 5)); }
__host__ __device__ __forceinline__ void stage_rc(int b, int& R, int& C) { const int st = b / 1024, sb = b % 1024, swz = sb ^ (((sb >> 9) & 1) << 5); R = (st >> 1) * 16 + swz / 64; C = (st & 1) * 32 + (swz % 64) / 2; }
__host__ __device__ __forceinline__ int perm32(int rho) { const int n = rho >> 4, i = rho & 15; return 8 * (i >> 2) + 4 * n + (i & 3); }

struct Unit { int pm, pn; };
struct Gemm { const bf16_t* A; const bf16_t* Bt; int M, N, K; };

struct StaticOrder {
    int nM, nN, nwg, G, c;
    __host__ __device__ void init(int M, int N, int G_, int c_) { nM = M / BM; nN = N / BM; nwg = nM * nN; G = G_; c = c_; }
    __host__ __device__ bool next(int i, Unit& u) const {
        const long L = (long)i * G + c; if (L >= nwg) return false;
        int wgid = (int)L; { const int q = nwg / NXCD, r = nwg % NXCD, xcd = wgid % NXCD, off = wgid / NXCD; wgid = (xcd < r ? xcd * (q + 1) : r * (q + 1) + (xcd - r) * q) + off; }
        const int nig = WGM * nN, gid = wgid / nig, fm = gid * WGM, gsz = (nM - fm) < WGM ? (nM - fm) : WGM;
        u.pm = fm + ((wgid % nig) % gsz); u.pn = (wgid % nig) / gsz; return true;
    }
    __device__ __forceinline__ void a_ready(const Unit&) const {}
    __device__ __forceinline__ void done(const Unit&) const {}
};

__device__ __forceinline__ unsigned cvt_pk_bf16(float lo, float hi) { unsigned r; asm volatile("v_cvt_pk_bf16_f32 %0, %1, %2" : "=v"(r) : "v"(lo), "v"(hi)); return r; }
typedef float f32x2 __attribute__((ext_vector_type(2)));
template <class Epi, class Sched, bool ALIGN_EPI = false, bool SP2 = false>
__device__ __forceinline__ void gemm_phase(PG8_LAS unsigned char* lds, const Gemm g, const Sched& S, const Epi& E, const int tid_in) {
    const int tid = tid_in, wid = __builtin_amdgcn_readfirstlane(tid >> 6), lane = tid & 63, wr = wid >> 2, wc = wid & 3, fr = lane & 15, fq = lane >> 4;
    const int K = g.K, nt = K / BK;
    unsigned voffA[2], voffB[2];
#pragma unroll
    for (int i = 0; i < 2; ++i) { int R, C; stage_rc(tid * 16 + i * 8192, R, C); const int Rb = Epi::PERM ? ((R & ~31) + perm32(R & 31)) : R;
        voffA[i] = (unsigned)(R * K + C) * 2u; voffB[i] = (unsigned)(Rb * K + C) * 2u; }
    const size_t kstep = (size_t)(BK * 2);
    const size_t hstep = (size_t)HALF * K * 2;
    const size_t tstep = 2 * hstep;
    const unsigned ldsw = (unsigned)wid * 1024u;
    const int aoff = lds_byte(wr * 64 + fr, fq * 8), boff = lds_byte(wc * 32 + fr, fq * 8);
#define PG8_SA(b, h) (((b) * 2 + (h)) * HTB)
#define PG8_SB(b, h) ((4 + (b) * 2 + (h)) * HTB)
#define PG8_STAGE(bufoff, gbase, voff) do { _Pragma("unroll") for (int _i = 0; _i < 2; ++_i) \
        __builtin_amdgcn_global_load_lds((const unsigned*)((const char*)(gbase) + (voff)[_i]), (PG8_LAS unsigned*)(lds + (bufoff) + ldsw + _i * 8192), 16, 0, 0); } while (0)
#define PG8_LDA(dst, b, h) do { _Pragma("unroll") for (int m = 0; m < 4; ++m) _Pragma("unroll") for (int k = 0; k < 2; ++k) dst[m][k] = *(const PG8_LAS bf16x8*)(lds + PG8_SA(b, h) + aoff + m * 2048 + k * 1024); } while (0)
#define PG8_LDB(dst, b, h) do { _Pragma("unroll") for (int n = 0; n < 2; ++n) _Pragma("unroll") for (int k = 0; k < 2; ++k) dst[n][k] = *(const PG8_LAS bf16x8*)(lds + PG8_SB(b, h) + boff + n * 2048 + k * 1024); } while (0)
#define PG8_MMA(ai, bj, At, Bt) do { __builtin_amdgcn_s_setprio(1); _Pragma("unroll") for (int m = 0; m < 4; ++m) _Pragma("unroll") for (int n = 0; n < 2; ++n) _Pragma("unroll") for (int k = 0; k < 2; ++k) \
        acc[ai][bj][m][n] = __builtin_amdgcn_mfma_f32_16x16x32_bf16(Bt[n][k], At[m][k], acc[ai][bj][m][n], 0, 0, 0); __builtin_amdgcn_s_setprio(0); } while (0)
#define PG8_WAIT_V(n) asm volatile("s_waitcnt vmcnt(" #n ")" ::: "memory")
#define PG8_WAIT_L(n) asm volatile("s_waitcnt lgkmcnt(" #n ")" ::: "memory")
#define PG8_BAR __builtin_amdgcn_s_barrier()
#define PG8_SCHED __builtin_amdgcn_sched_barrier(0)
    Unit cur, nxt; int ui = 0;
    if (!S.next(0, cur)) return;
    f32x4 acc[2][2][4][2];
#pragma unroll
    for (int a = 0; a < 2; ++a)
#pragma unroll
        for (int b = 0; b < 2; ++b)
#pragma unroll
            for (int m = 0; m < 4; ++m)
#pragma unroll
                for (int n = 0; n < 2; ++n) acc[a][b][m][n] = (f32x4){0.f, 0.f, 0.f, 0.f};
    bf16x8 At[4][2], B0[2][2], B1[2][2];
    const char* cA = (const char*)g.A + (size_t)cur.pm * tstep; const char* cB = (const char*)g.Bt + (size_t)cur.pn * tstep;
    S.a_ready(cur);
    if constexpr (SP2) {
        PG8_STAGE(PG8_SB(0, 0), cB, voffB); PG8_STAGE(PG8_SB(0, 1), cB + hstep, voffB); PG8_STAGE(PG8_SA(0, 0), cA, voffA); PG8_STAGE(PG8_SA(0, 1), cA + hstep, voffA);
        if (wr == 1) PG8_BAR;
        PG8_WAIT_V(2); PG8_BAR;
        PG8_STAGE(PG8_SB(1, 0), cB + kstep, voffB); PG8_STAGE(PG8_SA(1, 0), cA + kstep, voffA); PG8_STAGE(PG8_SB(1, 1), cB + hstep + kstep, voffB);
        PG8_WAIT_V(6); PG8_BAR;
    } else {
        PG8_STAGE(PG8_SB(0, 0), cB, voffB); PG8_STAGE(PG8_SA(0, 0), cA, voffA); PG8_STAGE(PG8_SB(0, 1), cB + hstep, voffB); PG8_STAGE(PG8_SA(0, 1), cA + hstep, voffA);
        if (wr == 1) PG8_BAR;
        PG8_WAIT_V(4); PG8_BAR;
        PG8_STAGE(PG8_SB(1, 0), cB + kstep, voffB); PG8_STAGE(PG8_SA(1, 0), cA + kstep, voffA); PG8_STAGE(PG8_SB(1, 1), cB + hstep + kstep, voffB);
        PG8_WAIT_V(6); PG8_BAR;
    }
    for (;;) {
        const bool has_next = S.next(ui + 1, nxt);
        const char* nA = has_next ? (const char*)g.A + (size_t)nxt.pm * tstep : cA; const char* nB = has_next ? (const char*)g.Bt + (size_t)nxt.pn * tstep : cB;
        for (int t = 0; t < nt; t += 2) {
            const bool last = (t == nt - 2);
            const char* a1 = cA + (size_t)(t + 1) * kstep;
            const char* a2 = last ? nA : cA + (size_t)(t + 2) * kstep; const char* b2 = last ? nB : cB + (size_t)(t + 2) * kstep;
            const char* a3 = a2 + kstep; const char* b3 = b2 + kstep;
            if (last && has_next) S.a_ready(nxt);
            if constexpr (SP2) {
            PG8_LDB(B0, 0, 0); PG8_LDB(B1, 0, 1); PG8_SCHED; PG8_LDA(At, 0, 0); PG8_STAGE(PG8_SA(1, 1), a1 + hstep, voffA);
            PG8_WAIT_V(8); PG8_WAIT_L(0); PG8_BAR; PG8_MMA(0, 0, At, B0); PG8_MMA(0, 1, At, B1); PG8_BAR; PG8_SCHED;
            PG8_LDA(At, 0, 1); PG8_STAGE(PG8_SB(0, 0), b2, voffB); PG8_STAGE(PG8_SB(0, 1), b2 + hstep, voffB); PG8_STAGE(PG8_SA(0, 0), a2, voffA);
            PG8_WAIT_V(8); PG8_WAIT_L(0); PG8_BAR; PG8_MMA(1, 0, At, B0); PG8_MMA(1, 1, At, B1); PG8_BAR; PG8_SCHED;
            PG8_LDB(B0, 1, 0); PG8_LDB(B1, 1, 1); PG8_SCHED; PG8_LDA(At, 1, 0); PG8_STAGE(PG8_SA(0, 1), a2 + hstep, voffA);
            PG8_WAIT_V(8); PG8_WAIT_L(0); PG8_BAR; PG8_MMA(0, 0, At, B0); PG8_MMA(0, 1, At, B1); PG8_BAR; PG8_SCHED;
            PG8_LDA(At, 1, 1); PG8_STAGE(PG8_SB(1, 0), b3, voffB); PG8_STAGE(PG8_SB(1, 1), b3 + hstep, voffB); PG8_STAGE(PG8_SA(1, 0), a3, voffA);
            PG8_WAIT_V(8); PG8_WAIT_L(0); PG8_BAR; PG8_MMA(1, 0, At, B0); PG8_MMA(1, 1, At, B1); PG8_BAR; PG8_SCHED;
            } else {
            PG8_LDB(B0, 0, 0); PG8_SCHED; PG8_LDA(At, 0, 0); PG8_STAGE(PG8_SA(1, 1), a1 + hstep, voffA);
            PG8_WAIT_L(8); PG8_BAR; PG8_WAIT_L(0); PG8_MMA(0, 0, At, B0); PG8_BAR; PG8_SCHED;
            PG8_LDB(B1, 0, 1); PG8_STAGE(PG8_SB(0, 0), b2, voffB);
            PG8_BAR; PG8_WAIT_L(0); PG8_MMA(0, 1, At, B1); PG8_BAR;
            PG8_LDA(At, 0, 1); PG8_STAGE(PG8_SA(0, 0), a2, voffA);
            PG8_BAR; PG8_WAIT_L(0); PG8_MMA(1, 0, At, B0); PG8_BAR; PG8_SCHED;
            PG8_STAGE(PG8_SB(0, 1), b2 + hstep, voffB);
            PG8_WAIT_V(6); PG8_BAR; PG8_MMA(1, 1, At, B1); PG8_BAR;
            PG8_LDB(B0, 1, 0); PG8_SCHED; PG8_LDA(At, 1, 0); PG8_STAGE(PG8_SA(0, 1), a2 + hstep, voffA);
            PG8_WAIT_L(8); PG8_BAR; PG8_WAIT_L(0); PG8_MMA(0, 0, At, B0); PG8_BAR; PG8_SCHED;
            PG8_LDB(B1, 1, 1); PG8_STAGE(PG8_SB(1, 0), b3, voffB);
            PG8_BAR; PG8_WAIT_L(0); PG8_MMA(0, 1, At, B1); PG8_BAR;
            PG8_LDA(At, 1, 1); PG8_STAGE(PG8_SA(1, 0), a3, voffA);
            PG8_BAR; PG8_WAIT_L(0); PG8_MMA(1, 0, At, B0); PG8_BAR; PG8_SCHED;
            PG8_STAGE(PG8_SB(1, 1), b3 + hstep, voffB);
            PG8_WAIT_V(6); PG8_BAR; PG8_MMA(1, 1, At, B1); PG8_BAR;
            }
        }
        if constexpr (ALIGN_EPI) { if (wr == 0) PG8_BAR; }
        if constexpr (!Epi::AFTER_DRAIN) { E(acc, cur, wr, wc, fr, fq); S.done(cur); }
        if (!has_next) break;
#pragma unroll
        for (int a = 0; a < 2; ++a)
#pragma unroll
            for (int b = 0; b < 2; ++b)
#pragma unroll
                for (int m = 0; m < 4; ++m)
#pragma unroll
                    for (int n = 0; n < 2; ++n) acc[a][b][m][n] = (f32x4){0.f, 0.f, 0.f, 0.f};
        cur = nxt; cA = nA; cB = nB; ++ui;
        if constexpr (ALIGN_EPI) { if (wr == 1) PG8_BAR; }
    }
    PG8_WAIT_V(0);
    if constexpr (!ALIGN_EPI) { if (wr == 0) PG8_BAR; }
    PG8_BAR;
    if constexpr (Epi::AFTER_DRAIN) { E.fused(acc, cur, wr, wc, fr, fq, lds, wid, lane); S.done(cur); }
#undef PG8_SA
#undef PG8_SB
#undef PG8_STAGE
#undef PG8_LDA
#undef PG8_LDB
#undef PG8_MMA
#undef PG8_WAIT_V
#undef PG8_WAIT_L
#undef PG8_BAR
#undef PG8_SCHED
}
}
#define LAS __attribute__((address_space(3)))
#define GAS __attribute__((address_space(1)))
#define GP(T, p) ((T*)(GAS T*)(p))
typedef unsigned short bf16;
typedef unsigned u32x4v __attribute__((ext_vector_type(4)));
typedef unsigned u32x2v __attribute__((ext_vector_type(2)));
typedef float f32x4 __attribute__((ext_vector_type(4)));
typedef float f32x2 __attribute__((ext_vector_type(2)));
typedef float f32x16 __attribute__((ext_vector_type(16)));
typedef short bf16x8 __attribute__((ext_vector_type(8)));
typedef short s16x4 __attribute__((ext_vector_type(4)));
typedef __bf16 bf16x2_t __attribute__((ext_vector_type(2)));

constexpr int M = 16384, D = 1024, SEQ = 8192, FF = 4096;
constexpr float EPS = 1e-6f;
constexpr float LOG2E = 1.4426950408889634f;
constexpr float QSCALE = 0.125f * LOG2E;

constexpr size_t MiB = 1u << 20;
constexpr size_t WS_CTL = 0, WS_STAT = 1 * MiB, WS_W = 2 * MiB, WS_XN = 28 * MiB, WS_UX = 60 * MiB, WS_Q = 92 * MiB, WS_V = 124 * MiB,
                 WS_GATE = 156 * MiB, WS_G = 188 * MiB, WS_HID = 92 * MiB, WS_VB = 220 * MiB, WS_U = 28 * MiB;
constexpr size_t W_A = 0, W_O = 8 * MiB, W_U = 10 * MiB, W_D = 18 * MiB;
constexpr size_t CTL_LBT = 0, CTL_BT = 65536, CTL_LAM = 98304, CTL_BAR = 131072, CTL_CNT = 262144  , CTL_ZERO_END = 524288;

constexpr int LDS_TOTAL = 131072 + 1024;

enum { K_PRO = 0, K_WIN, K_HA, K_HB, K_HC, K_YOUT, K_NORM1, K_UP, K_DOWN, K_NORM2, K_KVQ, K_QG, K_ATT, K_YOUTF, K_DOWNF, K_CONV };

struct Args { const float* in[20]; float* out; unsigned char* ws; int lo, hi; unsigned char kind[80]; unsigned char layer[80]; unsigned char cv[80]; };

__device__ __forceinline__ unsigned pk2(float lo, float hi) { f32x2 v = {lo, hi}; bf16x2_t b = __builtin_convertvector(v, bf16x2_t); return __builtin_bit_cast(unsigned, b); }
typedef _Float16 f16x2_t __attribute__((ext_vector_type(2)));
__device__ __forceinline__ unsigned pkh2(float lo, float hi) { f16x2_t v = {(_Float16)lo, (_Float16)hi}; return __builtin_bit_cast(unsigned, v); }
__device__ __forceinline__ float hlo(unsigned u) { return (float)__builtin_bit_cast(f16x2_t, u)[0]; }
__device__ __forceinline__ float hhi(unsigned u) { return (float)__builtin_bit_cast(f16x2_t, u)[1]; }
__device__ __forceinline__ float bflo(unsigned u) { return __uint_as_float(u << 16); }
__device__ __forceinline__ float bfhi(unsigned u) { return __uint_as_float(u & 0xffff0000u); }
__device__ __forceinline__ int crow(int r, int hi) { return (r & 3) + 8 * (r >> 2) + 4 * hi; }
__device__ __forceinline__ float wave_sum(float v) {
#pragma unroll
    for (int o = 1; o < 64; o <<= 1) v += __shfl_xor(v, o);
    return v;
}
#define MFMA32(a, b, c) __builtin_amdgcn_mfma_f32_32x32x16_bf16((a), (b), (c), 0, 0, 0)
#define MFMA16(a, b, c) __builtin_amdgcn_mfma_f32_16x16x32_bf16((a), (b), (c), 0, 0, 0)

struct EpiSplit {
    static constexpr bool PERM = true, AFTER_DRAIN = false;
    unsigned char* ws; int kvq;
    __device__ __forceinline__ void operator()(const pg8::f32x4 (&acc)[2][2][4][2], const pg8::Unit& u, int wr, int wc, int fr, int fq) const {
        const int seg = u.pn >> 2; size_t off = WS_Q; if (kvq && seg == 0) off = WS_UX; if (kvq && seg == 1) off = WS_VB;
        bf16* base = (bf16*)(ws + off);
        const int row0 = u.pm * 256 + wr * 64 + fr, col0 = (u.pn & 3) * 256 + wc * 32 + 8 * fq;
#pragma unroll
        for (int ai = 0; ai < 2; ++ai)
#pragma unroll
            for (int m = 0; m < 4; ++m) { bf16* rowp = base + (size_t)(row0 + ai * 128 + m * 16) * 1024 + col0;
#pragma unroll
                for (int bj = 0; bj < 2; ++bj) { const pg8::f32x4 v0 = acc[ai][bj][m][0], v1 = acc[ai][bj][m][1];
                    u32x4v w; w.x = pk2(v0[0], v0[1]); w.y = pk2(v0[2], v0[3]); w.z = pk2(v1[0], v1[1]); w.w = pk2(v1[2], v1[3]);
                    *(u32x4v*)(rowp + bj * 128) = w; } }
    }
};
struct EpiRelu2 {
    static constexpr bool PERM = true, AFTER_DRAIN = false;
    bf16* O;
    __device__ __forceinline__ void operator()(const pg8::f32x4 (&acc)[2][2][4][2], const pg8::Unit& u, int wr, int wc, int fr, int fq) const {
        const int row0 = u.pm * 256 + wr * 64 + fr, col0 = u.pn * 256 + wc * 32 + 8 * fq;
#pragma unroll
        for (int ai = 0; ai < 2; ++ai)
#pragma unroll
            for (int m = 0; m < 4; ++m) { bf16* rowp = O + (size_t)(row0 + ai * 128 + m * 16) * FF + col0;
#pragma unroll
                for (int bj = 0; bj < 2; ++bj) { pg8::f32x4 v0 = acc[ai][bj][m][0], v1 = acc[ai][bj][m][1];
#pragma unroll
                    for (int e = 0; e < 4; ++e) { const float a = fmaxf(v0[e], 0.f), b = fmaxf(v1[e], 0.f); v0[e] = a * a; v1[e] = b * b; }
                    u32x4v w; w.x = pk2(v0[0], v0[1]); w.y = pk2(v0[2], v0[3]); w.z = pk2(v1[0], v1[1]); w.w = pk2(v1[2], v1[3]);
                    *(u32x4v*)(rowp + bj * 128) = w; } }
    }
};
struct EpiY {
    static constexpr bool PERM = true, AFTER_DRAIN = false;
    bf16* O; float* stat;
    __device__ __forceinline__ void operator()(const pg8::f32x4 (&acc)[2][2][4][2], const pg8::Unit& u, int wr, int wc, int fr, int fq) const {
        const int row0 = u.pm * 256 + wr * 64 + fr, col0 = u.pn * 256 + wc * 32 + 8 * fq;
#pragma unroll
        for (int ai = 0; ai < 2; ++ai)
#pragma unroll
            for (int m = 0; m < 4; ++m) { const int row = row0 + ai * 128 + m * 16; bf16* rowp = O + (size_t)row * 1024 + col0; float ss = 0.f;
#pragma unroll
                for (int bj = 0; bj < 2; ++bj) { const pg8::f32x4 v0 = acc[ai][bj][m][0], v1 = acc[ai][bj][m][1];
                    ss += (v0[0] * v0[0] + v0[1] * v0[1]) + (v0[2] * v0[2] + v0[3] * v0[3]) + (v1[0] * v1[0] + v1[1] * v1[1]) + (v1[2] * v1[2] + v1[3] * v1[3]);
                    u32x4v w; w.x = pk2(v0[0], v0[1]); w.y = pk2(v0[2], v0[3]); w.z = pk2(v1[0], v1[1]); w.w = pk2(v1[2], v1[3]);
                    *(u32x4v*)(rowp + bj * 128) = w; }
                ss += __shfl_xor(ss, 16); ss += __shfl_xor(ss, 32);
                if (fq == 0) stat[(size_t)row * 16 + u.pn * 4 + wc] = ss; }
    }
};
__device__ __forceinline__ float silu_f(float x) { return x * __builtin_amdgcn_rcpf(1.f + __expf(-x)); }
struct EpiWin {
    static constexpr bool PERM = true, AFTER_DRAIN = false;
    unsigned char* ws; const float* lbt;
    __device__ __forceinline__ void operator()(const pg8::f32x4 (&acc)[2][2][4][2], const pg8::Unit& u, int wr, int wc, int fr, int fq) const {
        const int seg = u.pn >> 2;
        const int row0 = u.pm * 256 + wr * 64 + fr, col0 = (u.pn & 3) * 256 + wc * 32 + 8 * fq;
        if (seg == 1) {
#pragma unroll
            for (int bj = 0; bj < 2; ++bj) {
                float la[8], l1[8];
#pragma unroll
                for (int e = 0; e < 8; e += 2) { const f32x4 t = *(const f32x4*)(lbt + (size_t)(col0 + bj * 128 + e) * 2); la[e] = t[0]; l1[e] = t[1]; la[e + 1] = t[2]; l1[e + 1] = t[3]; }
#pragma unroll
                for (int ai = 0; ai < 2; ++ai)
#pragma unroll
                    for (int m = 0; m < 4; ++m) { bf16* rowp = (bf16*)(ws + WS_G) + (size_t)(row0 + ai * 128 + m * 16) * 1024 + col0 + bj * 128;
                        float o[8];
#pragma unroll
                        for (int n = 0; n < 2; ++n) { const pg8::f32x4 v = acc[ai][bj][m][n];
#pragma unroll
                            for (int e = 0; e < 4; ++e) { const float f = v[e];
                                const float ls = fminf(f, 0.f) - __logf(1.f + __expf(-fabsf(f)));
                                const float c = l1[4 * n + e] + ls, a = la[4 * n + e];
                                const float mx = fmaxf(a, c), df = fabsf(a - c);
                                o[4 * n + e] = mx + __logf(1.f + __expf(-df)); } }
                        u32x4v w; w.x = pkh2(o[0], o[1]); w.y = pkh2(o[2], o[3]); w.z = pkh2(o[4], o[5]); w.w = pkh2(o[6], o[7]);
                        *(u32x4v*)rowp = w; }
            }
        } else {
            size_t off = WS_Q; if (seg == 2) off = WS_V; if (seg == 3) off = WS_GATE; bf16* base = (bf16*)(ws + off);
#pragma unroll
            for (int ai = 0; ai < 2; ++ai)
#pragma unroll
                for (int m = 0; m < 4; ++m) { bf16* rowp = base + (size_t)(row0 + ai * 128 + m * 16) * 1024 + col0;
#pragma unroll
                    for (int bj = 0; bj < 2; ++bj) { pg8::f32x4 v0 = acc[ai][bj][m][0], v1 = acc[ai][bj][m][1];
                        if (seg != 2) {
#pragma unroll
                            for (int e = 0; e < 4; ++e) { v0[e] = silu_f(v0[e]); v1[e] = silu_f(v1[e]); } }
                        u32x4v w; w.x = pk2(v0[0], v0[1]); w.y = pk2(v0[2], v0[3]); w.z = pk2(v1[0], v1[1]); w.w = pk2(v1[2], v1[3]);
                        *(u32x4v*)(rowp + bj * 128) = w; } }
        }
    }
};

struct RowStatX {
    float* xbuf;
    unsigned* cnt;
    __device__ __forceinline__ void run(const pg8::f32x4 (&v)[2][2][4][2], const pg8::Unit& u, int wr, int wc, int fr, int fq, LAS unsigned char* lds, int wid, int lane) const {
        LAS float* P = (LAS float*)lds; LAS float* S = (LAS float*)(lds + 4096);
        const int tid = wid * 64 + lane;
#pragma unroll
        for (int ai = 0; ai < 2; ++ai)
#pragma unroll
            for (int m = 0; m < 4; ++m) { float s = 0.f;
#pragma unroll
                for (int bj = 0; bj < 2; ++bj)
#pragma unroll
                    for (int n = 0; n < 2; ++n) { const pg8::f32x4 x = v[ai][bj][m][n]; s += (x[0] * x[0] + x[1] * x[1]) + (x[2] * x[2] + x[3] * x[3]); }
                s += __shfl_xor(s, 16); s += __shfl_xor(s, 32);
                if (fq == 0) P[(ai * 128 + wr * 64 + m * 16 + fr) * 4 + wc] = s; }
        asm volatile("s_waitcnt lgkmcnt(0)" ::: "memory"); __builtin_amdgcn_s_barrier(); asm volatile("" ::: "memory");
        if (tid < 256) { const f32x4 p = *(const LAS f32x4*)(P + tid * 4);
            __hip_atomic_store(xbuf + (size_t)(u.pm * 256 + tid) * 4 + u.pn, (p[0] + p[1]) + (p[2] + p[3]), __ATOMIC_RELAXED, __HIP_MEMORY_SCOPE_AGENT); }
        asm volatile("s_waitcnt vmcnt(0)" ::: "memory");
        if (lane == 0) __hip_atomic_fetch_add(cnt + 64 * u.pm, 1u, __ATOMIC_RELAXED, __HIP_MEMORY_SCOPE_AGENT);
        if (wid == 0) {
            unsigned spins = 0;
            while ((unsigned)__builtin_amdgcn_readfirstlane(__hip_atomic_load(cnt + 64 * u.pm, __ATOMIC_RELAXED, __HIP_MEMORY_SCOPE_AGENT)) < 32u) { __builtin_amdgcn_s_sleep(2); if (++spins > (1u << 22)) break; }
            __builtin_amdgcn_fence(__ATOMIC_ACQUIRE, "agent");
        }
        asm volatile("s_waitcnt vmcnt(0) lgkmcnt(0)" ::: "memory"); __builtin_amdgcn_s_barrier(); asm volatile("" ::: "memory");
        if (tid < 256) { const float* slot = xbuf + (size_t)(u.pm * 256 + tid) * 4; float t = 0.f;
#pragma unroll
            for (int j = 0; j < 4; ++j) t += __hip_atomic_load(slot + j, __ATOMIC_RELAXED, __HIP_MEMORY_SCOPE_AGENT);
            S[tid] = rsqrtf(t * (1.f / 1024.f) + EPS); }
        asm volatile("s_waitcnt lgkmcnt(0)" ::: "memory"); __builtin_amdgcn_s_barrier(); asm volatile("" ::: "memory");
    }
};
struct EpiNormF {
    static constexpr bool PERM = false, AFTER_DRAIN = true;
    const float* hin; float* hout; bf16* xn; const float* wpost; RowStatX st1, st2;
    __device__ __forceinline__ void fused(pg8::f32x4 (&acc)[2][2][4][2], const pg8::Unit& u, int wr, int wc, int fr, int fq, LAS unsigned char* lds, int wid, int lane) const {
        const LAS float* S = (const LAS float*)(lds + 4096);
        const int col0 = u.pn * 256 + wc * 32 + 4 * fq;
        f32x4 pre[4][2][2];
#pragma unroll
        for (int m = 0; m < 4; ++m) { const size_t off = (size_t)(u.pm * 256 + wr * 64 + m * 16 + fr) * 1024 + col0;
#pragma unroll
            for (int bj = 0; bj < 2; ++bj)
#pragma unroll
                for (int n = 0; n < 2; ++n) pre[m][bj][n] = *(const f32x4*)(hin + off + bj * 128 + n * 16); }
        st1.run(acc, u, wr, wc, fr, fq, lds, wid, lane);
        f32x4 w[2][2];
#pragma unroll
        for (int bj = 0; bj < 2; ++bj)
#pragma unroll
            for (int n = 0; n < 2; ++n) w[bj][n] = *(const f32x4*)(wpost + col0 + bj * 128 + n * 16);
#pragma unroll
        for (int ai = 0; ai < 2; ++ai)
#pragma unroll
            for (int m = 0; m < 4; ++m) { const int r = ai * 128 + wr * 64 + m * 16 + fr; const float rs = S[r]; const size_t off = (size_t)(u.pm * 256 + r) * 1024 + col0;
#pragma unroll
                for (int bj = 0; bj < 2; ++bj)
#pragma unroll
                    for (int n = 0; n < 2; ++n) { const f32x4 bs = ai == 0 ? pre[m][bj][n] : *(const f32x4*)(hin + off + bj * 128 + n * 16);
                        const f32x4 hn = bs + acc[ai][bj][m][n] * rs * w[bj][n]; acc[ai][bj][m][n] = hn; *(f32x4*)(hout + off + bj * 128 + n * 16) = hn; }
                if (m & 1) asm volatile("" ::: "memory"); }
        if (xn) {
            st2.run(acc, u, wr, wc, fr, fq, lds, wid, lane);
#pragma unroll
            for (int ai = 0; ai < 2; ++ai)
#pragma unroll
                for (int m = 0; m < 4; ++m) { const int r = ai * 128 + wr * 64 + m * 16 + fr; const float rs = S[r]; const size_t off = (size_t)(u.pm * 256 + r) * 1024 + col0;
#pragma unroll
                    for (int bj = 0; bj < 2; ++bj)
#pragma unroll
                        for (int n = 0; n < 2; ++n) { const f32x4 o = acc[ai][bj][m][n] * rs; u32x2v pk; pk.x = pk2(o[0], o[1]); pk.y = pk2(o[2], o[3]); *(u32x2v*)(xn + off + bj * 128 + n * 16) = pk; } }
        }
    }
};

struct Frame {
    unsigned char* lds; LAS unsigned char* lds3;
    int tid, lane, wave, G, bid;
    const float* const* in; float* H; unsigned char* ws;
};

__device__ __forceinline__ void cvt_job(const Frame& F, const float* W, int K, int N, bf16* WT, const float* gain, int kmask, float scale) {
    LAS float* scr = (LAS float*)(F.lds3);
    const int tid = F.tid, nblk = N / 128, items = (K / 64) * nblk;
    for (int item = F.bid; item < items; item += F.G) {
        const int kb = item / nblk, nb = item % nblk, k0 = 64 * kb, n0 = 128 * nb;
        f32x4 v[4];
#pragma unroll
        for (int i = 0; i < 4; ++i) { const int kk = 16 * i + (tid >> 5);
            v[i] = __builtin_nontemporal_load((const f32x4*)(W + (size_t)(k0 + kk) * N + n0 + 4 * (tid & 31))); }
#pragma unroll
        for (int i = 0; i < 4; ++i) { const int kk = 16 * i + (tid >> 5); const float g = gain ? gain[(k0 + kk) & kmask] * scale : scale;
            LAS float* p = scr + kk * 129 + 4 * (tid & 31);
            p[0] = v[i][0] * g; p[1] = v[i][1] * g; p[2] = v[i][2] * g; p[3] = v[i][3] * g; }
        __syncthreads();
#pragma unroll
        for (int j = 0; j < 2; ++j) { const int idx = tid + 512 * j, n = idx >> 3, c = idx & 7; const LAS float* sp = scr + (8 * c) * 129 + n;
            u32x4v o; o.x = pk2(sp[0 * 129], sp[1 * 129]); o.y = pk2(sp[2 * 129], sp[3 * 129]); o.z = pk2(sp[4 * 129], sp[5 * 129]); o.w = pk2(sp[6 * 129], sp[7 * 129]);
            *(u32x4v*)(WT + (size_t)(n0 + n) * K + k0 + 8 * c) = o; }
        __syncthreads();
    }
}
__device__ __forceinline__ float lam_init_of(int layer) { float c = 0.8f; asm volatile("" : "+v"(c)); return c - 0.6f * __expf(-0.3f * (float)layer); }
__device__ __forceinline__ void convert_layer(const Frame& F, int L, int mask) {
    bf16* WA = (bf16*)(F.ws + WS_W + W_A); bf16* WO = (bf16*)(F.ws + WS_W + W_O); bf16* WU = (bf16*)(F.ws + WS_W + W_U); bf16* WD = (bf16*)(F.ws + WS_W + W_D);
    if (L < 2) {
        if (mask & 1) cvt_job(F, F.in[3] + (size_t)L * D * 4096, D, 4096, WA, F.in[1] + L * D, 1023, 1.f);
        if (mask & 2) cvt_job(F, F.in[6] + (size_t)L * D * D, D, D, WO, F.in[5] + L * 128, 127, 1.f);
    } else {
        const int bi = L - 2;
        if (mask & 1) {
            if (bi == 0) {
                cvt_job(F, F.in[8], D, 2048, WA, F.in[7], 1023, 1.f);
                cvt_job(F, F.in[11], D, D, WA + (size_t)2048 * D, F.in[9], 1023, QSCALE);
            } else {
                cvt_job(F, F.in[11] + (size_t)bi * D * D, D, D, WA, F.in[9] + bi * D, 1023, QSCALE);
            }
        }
        if (mask & 2) cvt_job(F, F.in[14] + (size_t)bi * D * D, D, D, WO, F.in[13] + bi * 128, 127, 1.f - lam_init_of(L));
    }
    if (mask & 4) cvt_job(F, F.in[18] + (size_t)L * D * FF, D, FF, WU, F.in[16] + L * D, 1023, 1.f);
    if (mask & 8) cvt_job(F, F.in[19] + (size_t)L * FF * D, FF, D, WD, nullptr, 0, 1.f);
    __syncthreads();
}

#ifdef NORM2ROW
__device__ __forceinline__ void norm_pass(const Frame& F, const float* hin, const bf16* Y, const float* stat, const float* wpost, float* hout, bf16* xn) {
    const int gw = F.bid * 8 + F.wave, NGW = F.G * 8, lane = F.lane;
    f32x4 w[4];
    if (Y) { const float* wp = wpost + 8 * lane; w[0] = *(const f32x4*)wp; w[1] = *(const f32x4*)(wp + 4); w[2] = *(const f32x4*)(wp + 512); w[3] = *(const f32x4*)(wp + 516); }
    for (int row0 = gw; row0 < M; row0 += 2 * NGW) {
        f32x4 h[2][4]; u32x4v y0[2], y1[2]; float sp[2];
        const int row1 = row0 + NGW; const bool has1 = row1 < M;
#pragma unroll
        for (int q = 0; q < 2; ++q) { const int row = q ? (has1 ? row1 : row0) : row0;
            const float* hp = hin + (size_t)row * D + 8 * lane;
            h[q][0] = *(const f32x4*)(hp); h[q][1] = *(const f32x4*)(hp + 4); h[q][2] = *(const f32x4*)(hp + 512); h[q][3] = *(const f32x4*)(hp + 516);
            if (Y) { const bf16* yp = Y + (size_t)row * D + 8 * lane; y0[q] = *(const u32x4v*)yp; y1[q] = *(const u32x4v*)(yp + 512);
                sp[q] = (lane < 16) ? stat[(size_t)row * 16 + lane] : 0.f; } }
#pragma unroll
        for (int q = 0; q < 2; ++q) {
            if (q == 1 && !has1) break;
            const int row = q ? row1 : row0;
            if (Y) {
                const float rs = rsqrtf(wave_sum(sp[q]) * (1.f / 1024.f) + EPS);
                const u32x4v a = y0[q], b = y1[q];
                h[q][0][0] += bflo(a.x) * rs * w[0][0]; h[q][0][1] += bfhi(a.x) * rs * w[0][1]; h[q][0][2] += bflo(a.y) * rs * w[0][2]; h[q][0][3] += bfhi(a.y) * rs * w[0][3];
                h[q][1][0] += bflo(a.z) * rs * w[1][0]; h[q][1][1] += bfhi(a.z) * rs * w[1][1]; h[q][1][2] += bflo(a.w) * rs * w[1][2]; h[q][1][3] += bfhi(a.w) * rs * w[1][3];
                h[q][2][0] += bflo(b.x) * rs * w[2][0]; h[q][2][1] += bfhi(b.x) * rs * w[2][1]; h[q][2][2] += bflo(b.y) * rs * w[2][2]; h[q][2][3] += bfhi(b.y) * rs * w[2][3];
                h[q][3][0] += bflo(b.z) * rs * w[3][0]; h[q][3][1] += bfhi(b.z) * rs * w[3][1]; h[q][3][2] += bflo(b.w) * rs * w[3][2]; h[q][3][3] += bfhi(b.w) * rs * w[3][3];
            }
            if (hout) { float* op = hout + (size_t)row * D + 8 * lane;
                *(f32x4*)op = h[q][0]; *(f32x4*)(op + 4) = h[q][1]; *(f32x4*)(op + 512) = h[q][2]; *(f32x4*)(op + 516) = h[q][3]; }
            if (xn) {
                float ss = 0.f;
#pragma unroll
                for (int j = 0; j < 4; ++j) ss += (h[q][j][0] * h[q][j][0] + h[q][j][1] * h[q][j][1]) + (h[q][j][2] * h[q][j][2] + h[q][j][3] * h[q][j][3]);
                const float r = rsqrtf(wave_sum(ss) * (1.f / 1024.f) + EPS);
                u32x4v o0, o1;
                o0.x = pk2(h[q][0][0] * r, h[q][0][1] * r); o0.y = pk2(h[q][0][2] * r, h[q][0][3] * r); o0.z = pk2(h[q][1][0] * r, h[q][1][1] * r); o0.w = pk2(h[q][1][2] * r, h[q][1][3] * r);
                o1.x = pk2(h[q][2][0] * r, h[q][2][1] * r); o1.y = pk2(h[q][2][2] * r, h[q][2][3] * r); o1.z = pk2(h[q][3][0] * r, h[q][3][1] * r); o1.w = pk2(h[q][3][2] * r, h[q][3][3] * r);
                bf16* xp = xn + (size_t)row * D + 8 * lane;
                *(u32x4v*)xp = o0; *(u32x4v*)(xp + 512) = o1;
            }
        }
    }
}

#else
__device__ __forceinline__ void norm_pass(const Frame& F, const float* hin, const bf16* Y, const float* stat, const float* wpost, float* hout, bf16* xn) {
    const int gw = F.bid * 8 + F.wave, NGW = F.G * 8, lane = F.lane;
    for (int row = gw; row < M; row += NGW) {
        f32x4 h[4];
        const float* hp = hin + (size_t)row * D + 8 * lane;
        h[0] = __builtin_nontemporal_load((const f32x4*)(hp)); h[1] = __builtin_nontemporal_load((const f32x4*)(hp + 4)); h[2] = __builtin_nontemporal_load((const f32x4*)(hp + 512)); h[3] = __builtin_nontemporal_load((const f32x4*)(hp + 516));
        if (Y) {
            const bf16* yp = Y + (size_t)row * D + 8 * lane;
            const u32x4v y0 = *(const u32x4v*)yp, y1 = *(const u32x4v*)(yp + 512);
            float sp = (lane < 16) ? stat[(size_t)row * 16 + lane] : 0.f;
            const float rs = rsqrtf(wave_sum(sp) * (1.f / 1024.f) + EPS);
            const float* wp = wpost + 8 * lane;
            const f32x4 w0 = *(const f32x4*)wp, w1 = *(const f32x4*)(wp + 4), w2 = *(const f32x4*)(wp + 512), w3 = *(const f32x4*)(wp + 516);
            h[0][0] += bflo(y0.x) * rs * w0[0]; h[0][1] += bfhi(y0.x) * rs * w0[1]; h[0][2] += bflo(y0.y) * rs * w0[2]; h[0][3] += bfhi(y0.y) * rs * w0[3];
            h[1][0] += bflo(y0.z) * rs * w1[0]; h[1][1] += bfhi(y0.z) * rs * w1[1]; h[1][2] += bflo(y0.w) * rs * w1[2]; h[1][3] += bfhi(y0.w) * rs * w1[3];
            h[2][0] += bflo(y1.x) * rs * w2[0]; h[2][1] += bfhi(y1.x) * rs * w2[1]; h[2][2] += bflo(y1.y) * rs * w2[2]; h[2][3] += bfhi(y1.y) * rs * w2[3];
            h[3][0] += bflo(y1.z) * rs * w3[0]; h[3][1] += bfhi(y1.z) * rs * w3[1]; h[3][2] += bflo(y1.w) * rs * w3[2]; h[3][3] += bfhi(y1.w) * rs * w3[3];
        }
        if (hout) { float* op = hout + (size_t)row * D + 8 * lane;
            *(f32x4*)op = h[0]; *(f32x4*)(op + 4) = h[1]; *(f32x4*)(op + 512) = h[2]; *(f32x4*)(op + 516) = h[3]; }
        if (xn) {
            float ss = 0.f;
#pragma unroll
            for (int j = 0; j < 4; ++j) ss += (h[j][0] * h[j][0] + h[j][1] * h[j][1]) + (h[j][2] * h[j][2] + h[j][3] * h[j][3]);
            const float r = rsqrtf(wave_sum(ss) * (1.f / 1024.f) + EPS);
            u32x4v o0, o1;
            o0.x = pk2(h[0][0] * r, h[0][1] * r); o0.y = pk2(h[0][2] * r, h[0][3] * r); o0.z = pk2(h[1][0] * r, h[1][1] * r); o0.w = pk2(h[1][2] * r, h[1][3] * r);
            o1.x = pk2(h[2][0] * r, h[2][1] * r); o1.y = pk2(h[2][2] * r, h[2][3] * r); o1.z = pk2(h[3][0] * r, h[3][1] * r); o1.w = pk2(h[3][2] * r, h[3][3] * r);
            bf16* xp = xn + (size_t)row * D + 8 * lane;
            *(u32x4v*)xp = o0; *(u32x4v*)(xp + 512) = o1;
        }
    }
}

#endif
__device__ __forceinline__ int rel_bucket_dev(int rel) {
    const int n = rel < 0 ? -rel : rel; int b;
    if (n < 8) b = n; else { const int lg = 31 - __clz(n * n); int large = 8 + (lg - 6); b = large < 15 ? large : 15; }
    return (rel > 0 ? 16 : 0) + b;
}
__device__ __forceinline__ void prologue_tables(const Frame& F) {
    const int gt = F.bid * 512 + F.tid, NT = F.G * 512;
    float* lbt = (float*)(F.ws + WS_CTL + CTL_LBT);
    float* bt = (float*)(F.ws + WS_CTL + CTL_BT);
    const float* a_lb = F.in[4]; const float* rb = F.in[15];
    for (int i = gt; i < 2048; i += NT) { const int a = i >> 10, col = i & 1023;
        const float x0 = a_lb[col], x1 = a_lb[1024 + col], mx = fmaxf(x0, x1), e0 = __expf(x0 - mx), e1 = __expf(x1 - mx);
        const float s0 = e0 / (e0 + e1), s1 = e1 / (e0 + e1);
        const float lb = (a == 0) ? 0.f : ((s0 + s1) - s0);
        lbt[2 * i] = (lb > 0.f) ? logf(lb) : -INFINITY; lbt[2 * i + 1] = log1pf(-lb); }
    if (F.bid == 0 && F.wave < 2) { const float* lp = F.in[12] + (size_t)F.wave * 256; const int lane = F.lane;
        const float a = wave_sum(lp[lane] * lp[64 + lane]), b2 = wave_sum(lp[128 + lane] * lp[192 + lane]);
        if (lane == 0) ((float*)(F.ws + WS_CTL + CTL_LAM))[F.wave] = __expf(a) - __expf(b2) + lam_init_of(F.wave + 2); }
    for (int i = gt; i < 4096; i += NT) { const int hm = i >> 8, d = i & 255, rel = d - 192;
        bt[i] = (rb[rel_bucket_dev(rel) * 16 + hm] - rb[15 * 16 + hm]) * LOG2E; }
}

typedef short v4i16_t __attribute__((ext_vector_type(4)));
__device__ __forceinline__ s16x4 vtr(LAS const unsigned char* p) { return __builtin_bit_cast(s16x4, __builtin_amdgcn_ds_read_tr16_b64_v4i16((LAS v4i16_t*)p)); }
constexpr int HL_B = 0, HL_SEG = 33792, HL_Q = 35840, HL_VT = 53248  , HL_ST = 73728, HL_P = 108544;
constexpr int BST = 132;
constexpr int QST = 136;
constexpr int VST = 72;
constexpr int HVS = 160;

__device__ __forceinline__ void chunk_cumsum(LAS float* B, LAS float* SEG, int tid) {
    const int seg = tid >> 7, k = tid & 127;
    float v[16];
#pragma unroll
    for (int i = 0; i < 16; ++i) v[i] = B[(seg * 16 + i) * BST + k];
#pragma unroll
    for (int i = 1; i < 16; ++i) v[i] += v[i - 1];
    SEG[seg * 128 + k] = v[15];
    __syncthreads();
    float off = 0.f;
    for (int s2 = 0; s2 < seg; ++s2) off += SEG[s2 * 128 + k];
#pragma unroll
    for (int i = 0; i < 16; ++i) B[(seg * 16 + i) * BST + k] = v[i] + off;
    __syncthreads();
}
__device__ __forceinline__ void load_g_tile(LAS float* B, const float* G, int rowbase, int colbase, int tid) {
#pragma unroll
    for (int i = 0; i < 4; ++i) { const int idx = tid + i * 512, t = idx >> 5, kq = idx & 31;
        *(LAS f32x4*)(B + t * BST + 4 * kq) = *(const f32x4*)(G + (size_t)(rowbase + t) * D + colbase + 4 * kq); }
}
__device__ __forceinline__ void load_v_tile_T(LAS bf16* Vt, const bf16* V, int rowbase, int colbase, int tid) {
#pragma unroll
    for (int i = 0; i < 2; ++i) { const int idx = tid + i * 512, s = idx >> 4, vq = idx & 15;
        const u32x4v w = *(const u32x4v*)(V + (size_t)(rowbase + s) * D + colbase + 8 * vq);
        LAS bf16* p = Vt + (8 * vq) * VST + s;
        p[0 * VST] = (bf16)(w.x & 0xffff); p[1 * VST] = (bf16)(w.x >> 16); p[2 * VST] = (bf16)(w.y & 0xffff); p[3 * VST] = (bf16)(w.y >> 16);
        p[4 * VST] = (bf16)(w.z & 0xffff); p[5 * VST] = (bf16)(w.z >> 16); p[6 * VST] = (bf16)(w.w & 0xffff); p[7 * VST] = (bf16)(w.w >> 16); }
}

__device__ __forceinline__ void hgrn_pass_a(const Frame& F) {
    LAS float* B = (LAS float*)(F.lds3 + HL_B); LAS float* SEG = (LAS float*)(F.lds3 + HL_SEG); LAS bf16* Vt = (LAS bf16*)(F.lds3 + HL_VT); LAS bf16* Ut = (LAS bf16*)(F.lds3 + HL_ST);
    const bf16* G = (const bf16*)(F.ws + WS_G); const bf16* V = (const bf16*)(F.ws + WS_V);
    bf16* Ug = (bf16*)(F.ws + WS_U); float* Dg = (float*)(F.ws + WS_STAT);
    const int tid = F.tid, lane = F.lane, wid = F.wave, r = lane & 31, hh = lane >> 5;
    u32x4v gq[2], vq[2];
#define HA_ISSUE(uu) do { const int h_ = (uu) & 7, c_ = ((uu) >> 3) & 127, b_ = (uu) >> 10, rb_ = b_ * SEQ + c_ * 64, cb_ = h_ * 128; \
        _Pragma("unroll") for (int i = 0; i < 2; ++i) { const int idx = tid + i * 512, s_ = idx >> 4, vq_ = idx & 15; gq[i] = *(const u32x4v*)(G + (size_t)(rb_ + s_) * D + cb_ + 8 * vq_); vq[i] = *(const u32x4v*)(V + (size_t)(rb_ + s_) * D + cb_ + 8 * vq_); } } while (0)
#define HA_WRITE() do { _Pragma("unroll") for (int i = 0; i < 2; ++i) { const int idx = tid + i * 512, s_ = idx >> 4, vq_ = idx & 15; const u32x4v gw = gq[i]; \
            *(LAS f32x4*)(B + s_ * BST + 8 * vq_) = (f32x4){hlo(gw.x), hhi(gw.x), hlo(gw.y), hhi(gw.y)}; *(LAS f32x4*)(B + s_ * BST + 8 * vq_ + 4) = (f32x4){hlo(gw.z), hhi(gw.z), hlo(gw.w), hhi(gw.w)}; \
            *(LAS u32x4v*)(Vt + s_ * HVS + 8 * vq_) = vq[i]; } } while (0)
    if (F.bid < 2048) { HA_ISSUE(F.bid); HA_WRITE(); if (F.bid + F.G < 2048) HA_ISSUE(F.bid + F.G); }
    __syncthreads();
    for (int u = F.bid; u < 2048; u += F.G) {
        const int h = u & 7, c = (u >> 3) & 127, b = u >> 10;
        const int su = (b * 8 + h) * 128 + c;
        chunk_cumsum(B, SEG, tid);
        const int kb = wid & 3, vh = wid >> 2, kcol = 32 * kb + r;
        const float bl = B[63 * BST + kcol];
        f32x16 acc0 = {}, acc1 = {};
#pragma unroll
        for (int s4 = 0; s4 < 4; ++s4) {
            float val[8];
#pragma unroll
            for (int j = 0; j < 8; ++j) { const int s = 16 * s4 + 8 * hh + j; const float bc = B[s * BST + kcol];
                const float bp = (s > 0) ? B[(s > 0 ? s - 1 : 0) * BST + kcol] : 0.f;
                val[j] = (1.f - __expf(bc - bp)) * __expf(bl - bc); }
            u32x4v aw; aw.x = pk2(val[0], val[1]); aw.y = pk2(val[2], val[3]); aw.z = pk2(val[4], val[5]); aw.w = pk2(val[6], val[7]);
            const bf16x8 a = __builtin_bit_cast(bf16x8, aw);
            LAS const unsigned char* vtb = (LAS const unsigned char*)Vt + (16 * s4 + 8 * hh + ((lane & 15) >> 2)) * (HVS * 2) + (64 * vh + 16 * ((lane >> 4) & 1)) * 2 + 8 * (lane & 3);
            const s16x4 l0 = vtr(vtb), h0 = vtr(vtb + 4 * HVS * 2), l1 = vtr(vtb + 64), h1 = vtr(vtb + 4 * HVS * 2 + 64);
            const bf16x8 b0 = __builtin_shufflevector(l0, h0, 0, 1, 2, 3, 4, 5, 6, 7), b1 = __builtin_shufflevector(l1, h1, 0, 1, 2, 3, 4, 5, 6, 7);
            acc0 = MFMA32(a, b0, acc0); acc1 = MFMA32(a, b1, acc1);
        }
#pragma unroll
        for (int g4 = 0; g4 < 4; ++g4) { const int k0 = 32 * kb + 8 * g4 + 4 * hh;
            u32x2v w0, w1; w0.x = pk2(acc0[4 * g4], acc0[4 * g4 + 1]); w0.y = pk2(acc0[4 * g4 + 2], acc0[4 * g4 + 3]);
            w1.x = pk2(acc1[4 * g4], acc1[4 * g4 + 1]); w1.y = pk2(acc1[4 * g4 + 2], acc1[4 * g4 + 3]);
            *(LAS u32x2v*)(Ut + (64 * vh + r) * QST + k0) = w0; *(LAS u32x2v*)(Ut + (64 * vh + 32 + r) * QST + k0) = w1; }
        if (tid < 128) Dg[(size_t)su * 128 + tid] = __expf(B[63 * BST + tid]);
        __syncthreads();
        if (u + F.G < 2048) { HA_WRITE(); if (u + 2 * F.G < 2048) HA_ISSUE(u + 2 * F.G); }
#pragma unroll
        for (int i = 0; i < 4; ++i) { const int idx = tid + i * 512, v = idx >> 4, kq = idx & 15;
            *(u32x4v*)(Ug + (size_t)su * 16384 + v * 128 + 8 * kq) = *(const LAS u32x4v*)(Ut + v * QST + 8 * kq); }
        __syncthreads();
    }
#undef HA_WRITE
}
__device__ __forceinline__ void hgrn_pass_b(const Frame& F, int dry) {
    unsigned* Ug = (unsigned*)(F.ws + WS_U); const float* Dg = (const float*)(F.ws + WS_STAT);
    for (int gid = F.bid * 512 + F.tid; gid < 16 * 8192; gid += F.G * 512) {
        const int chain = gid >> 13, e2 = gid & 8191, k = (2 * e2) & 127;
        unsigned* p = Ug + (size_t)chain * 128 * 8192 + e2; const float* dp = Dg + (size_t)chain * 128 * 128 + k;
        float s0 = 0.f, s1 = 0.f;
        for (int c0 = 0; c0 < 128; c0 += 8) {
            unsigned uu[8]; f32x2 dd[8];
#pragma unroll
            for (int j = 0; j < 8; ++j) { uu[j] = p[(size_t)(c0 + j) * 8192]; dd[j] = *(const f32x2*)(dp + (c0 + j) * 128); }
#pragma unroll
            for (int j = 0; j < 8; ++j) { if (!dry) p[(size_t)(c0 + j) * 8192] = pk2(s0, s1); s0 = dd[j][0] * s0 + bflo(uu[j]); s1 = dd[j][1] * s1 + bfhi(uu[j]); }
        }
    }
}
__device__ __forceinline__ void hgrn_pass_c(const Frame& F, int dry) {
    LAS float* B = (LAS float*)(F.lds3 + HL_B); LAS float* SEG = (LAS float*)(F.lds3 + HL_SEG); LAS bf16* Qs = (LAS bf16*)(F.lds3 + HL_Q); LAS bf16* Vt = (LAS bf16*)(F.lds3 + HL_VT);
    LAS bf16* St = (LAS bf16*)(F.lds3 + HL_ST); LAS bf16* P = (LAS bf16*)(F.lds3 + HL_P);
    const bf16* G = (const bf16*)(F.ws + WS_G); const bf16* V = (const bf16*)(F.ws + WS_V); bf16* Qg = (bf16*)(F.ws + WS_Q); const bf16* Gate = (const bf16*)(F.ws + WS_GATE);
    const bf16* Sg = (const bf16*)(F.ws + WS_U);
    const int tid = F.tid, lane = F.lane, wid = F.wave;
    u32x4v gq[2], vq[2], qq[2], sq[4];
#define HC_ISSUE(uu) do { const int h_ = (uu) & 7, c_ = ((uu) >> 3) & 127, b_ = (uu) >> 10, rb_ = b_ * SEQ + c_ * 64, cb_ = h_ * 128, su_ = (b_ * 8 + h_) * 128 + c_; \
        _Pragma("unroll") for (int i = 0; i < 2; ++i) { const int idx = tid + i * 512, s_ = idx >> 4, c16 = idx & 15; gq[i] = *(const u32x4v*)(G + (size_t)(rb_ + s_) * D + cb_ + 8 * c16); vq[i] = *(const u32x4v*)(V + (size_t)(rb_ + s_) * D + cb_ + 8 * c16); \
            qq[i] = *(const u32x4v*)(Qg + (size_t)(rb_ + s_) * D + cb_ + 8 * c16); } \
        _Pragma("unroll") for (int i = 0; i < 4; ++i) { const int idx = tid + i * 512, v_ = idx >> 4, kq = idx & 15; sq[i] = *(const u32x4v*)(Sg + (size_t)su_ * 16384 + v_ * 128 + 8 * kq); } } while (0)
#define HC_WRITE_A() do { _Pragma("unroll") for (int i = 0; i < 2; ++i) { const int idx = tid + i * 512, s_ = idx >> 4, c16 = idx & 15; const u32x4v gw = gq[i]; \
            *(LAS f32x4*)(B + s_ * BST + 8 * c16) = (f32x4){hlo(gw.x), hhi(gw.x), hlo(gw.y), hhi(gw.y)}; *(LAS f32x4*)(B + s_ * BST + 8 * c16 + 4) = (f32x4){hlo(gw.z), hhi(gw.z), hlo(gw.w), hhi(gw.w)}; \
            *(LAS u32x4v*)(Vt + s_ * HVS + 8 * c16) = vq[i]; *(LAS u32x4v*)(Qs + s_ * QST + 8 * c16) = qq[i]; } \
        { unsigned zz = 0u; asm volatile("" : "+v"(zz)); for (int idx = tid; idx < 576; idx += 512) *(LAS u32x4v*)(P + idx * 8) = (u32x4v){zz, zz, zz, zz}; } } while (0)
#define HC_WRITE_S() do { _Pragma("unroll") for (int i = 0; i < 4; ++i) { const int idx = tid + i * 512, v_ = idx >> 4, kq = idx & 15; *(LAS u32x4v*)(St + v_ * QST + 8 * kq) = sq[i]; } } while (0)
    if (F.bid < 2048) { HC_ISSUE(F.bid); HC_WRITE_A(); HC_WRITE_S(); if (F.bid + F.G < 2048) HC_ISSUE(F.bid + F.G); }
    __syncthreads();
    for (int u = F.bid; u < 2048; u += F.G) {
        const int h = u & 7, c = (u >> 3) & 127, b = u >> 10;
        const int rowbase = b * SEQ + c * 64, colbase = h * 128;
        const size_t goff = (size_t)(rowbase + (tid >> 3)) * D + colbase + 16 * (tid & 7);
        const u32x4v g0 = *(const u32x4v*)(Gate + goff), g1 = *(const u32x4v*)(Gate + goff + 8);
        chunk_cumsum(B, SEG, tid);
        for (int blk = wid; blk < 10; blk += 8) {
            int T, Sb; if (blk < 4) { T = blk; Sb = 0; } else if (blk < 7) { T = blk - 3; Sb = 1; } else if (blk < 9) { T = blk - 5; Sb = 2; } else { T = 3; Sb = 3; }
            const int r16 = lane & 15, gq = lane >> 4, t = 16 * T + r16, s = 16 * Sb + r16, sp = s > 0 ? s - 1 : 0;
            f32x4 acc = {0.f, 0.f, 0.f, 0.f};
#pragma unroll
            for (int ks = 0; ks < 4; ++ks) { const int k0 = 32 * ks + 8 * gq;
                const f32x4 br0 = *(const LAS f32x4*)(B + (16 * Sb + 15) * BST + k0), br1 = *(const LAS f32x4*)(B + (16 * Sb + 15) * BST + k0 + 4);
                const f32x4 bt0 = *(const LAS f32x4*)(B + t * BST + k0), bt1 = *(const LAS f32x4*)(B + t * BST + k0 + 4);
                const f32x4 bs0 = *(const LAS f32x4*)(B + s * BST + k0), bs1 = *(const LAS f32x4*)(B + s * BST + k0 + 4);
                f32x4 bp0 = *(const LAS f32x4*)(B + sp * BST + k0), bp1 = *(const LAS f32x4*)(B + sp * BST + k0 + 4);
                if (s == 0) { bp0 = (f32x4){0.f, 0.f, 0.f, 0.f}; bp1 = bp0; }
                const u32x4v qw = *(const LAS u32x4v*)(Qs + t * QST + k0);
                float qa[8] = {bflo(qw.x), bfhi(qw.x), bflo(qw.y), bfhi(qw.y), bflo(qw.z), bfhi(qw.z), bflo(qw.w), bfhi(qw.w)};
                float av[8], bv[8];
#pragma unroll
                for (int e = 0; e < 4; ++e) {
                    av[e] = qa[e] * __expf(bt0[e] - br0[e]); av[4 + e] = qa[4 + e] * __expf(bt1[e] - br1[e]);
                    bv[e] = (1.f - __expf(bs0[e] - bp0[e])) * __expf(br0[e] - bs0[e]); bv[4 + e] = (1.f - __expf(bs1[e] - bp1[e])) * __expf(br1[e] - bs1[e]); }
                u32x4v aw, bw; aw.x = pk2(av[0], av[1]); aw.y = pk2(av[2], av[3]); aw.z = pk2(av[4], av[5]); aw.w = pk2(av[6], av[7]);
                bw.x = pk2(bv[0], bv[1]); bw.y = pk2(bv[2], bv[3]); bw.z = pk2(bv[4], bv[5]); bw.w = pk2(bv[6], bv[7]);
                acc = MFMA16(__builtin_bit_cast(bf16x8, aw), __builtin_bit_cast(bf16x8, bw), acc);
            }
#pragma unroll
            for (int i = 0; i < 4; ++i) { float v = acc[i]; if (T == Sb && r16 > 4 * gq + i) v = 0.f;
                P[(16 * T + 4 * gq + i) * VST + 16 * Sb + r16] = (bf16)(pk2(v, 0.f) & 0xffff); }
        }
        const int r = lane & 31, hh = lane >> 5, tb = wid & 1, vb = wid >> 1, t32 = 32 * tb + r;
        f32x16 o = {};
#pragma unroll
        for (int ks = 0; ks < 8; ++ks) { const int k0 = 16 * ks + 8 * hh;
            const f32x4 b0 = *(const LAS f32x4*)(B + t32 * BST + k0), b1 = *(const LAS f32x4*)(B + t32 * BST + k0 + 4);
            const u32x4v qw = *(const LAS u32x4v*)(Qs + t32 * QST + k0);
            u32x4v aw;
            aw.x = pk2(bflo(qw.x) * __expf(b0[0]), bfhi(qw.x) * __expf(b0[1])); aw.y = pk2(bflo(qw.y) * __expf(b0[2]), bfhi(qw.y) * __expf(b0[3]));
            aw.z = pk2(bflo(qw.z) * __expf(b1[0]), bfhi(qw.z) * __expf(b1[1])); aw.w = pk2(bflo(qw.w) * __expf(b1[2]), bfhi(qw.w) * __expf(b1[3]));
            const bf16x8 bfr = *(const LAS bf16x8*)(St + (32 * vb + r) * QST + k0);
            o = MFMA32(__builtin_bit_cast(bf16x8, aw), bfr, o);
        }
        __syncthreads();
#pragma unroll
        for (int ss = 0; ss < 4; ++ss) {
            const bf16x8 a = *(const LAS bf16x8*)(P + t32 * VST + 16 * ss + 8 * hh);
            LAS const unsigned char* vtb = (LAS const unsigned char*)Vt + (16 * ss + 8 * hh + ((lane & 15) >> 2)) * (HVS * 2) + (32 * vb + 16 * ((lane >> 4) & 1)) * 2 + 8 * (lane & 3);
            const s16x4 l0 = vtr(vtb), h0 = vtr(vtb + 4 * HVS * 2);
            const bf16x8 bfr = __builtin_shufflevector(l0, h0, 0, 1, 2, 3, 4, 5, 6, 7);
            o = MFMA32(a, bfr, o);
        }
        LAS float* OT = (LAS float*)(F.lds3 + HL_ST);
#pragma unroll
        for (int i = 0; i < 16; ++i) OT[(32 * tb + crow(i, hh)) * BST + 32 * vb + r] = o[i];
        __syncthreads();
        if (u + F.G < 2048) HC_WRITE_A();
        {
            const int t = tid >> 3, vq = tid & 7;
            f32x4 x[4]; float ss = 0.f;
#pragma unroll
            for (int j = 0; j < 4; ++j) { x[j] = *(const LAS f32x4*)(OT + t * BST + 16 * vq + 4 * j); ss += (x[j][0] * x[j][0] + x[j][1] * x[j][1]) + (x[j][2] * x[j][2] + x[j][3] * x[j][3]); }
            ss += __shfl_xor(ss, 1); ss += __shfl_xor(ss, 2); ss += __shfl_xor(ss, 4);
            const float rs = rsqrtf(ss * (1.f / 128.f) + EPS);
            u32x4v o0, o1;
            o0.x = pk2(x[0][0] * rs * bflo(g0.x), x[0][1] * rs * bfhi(g0.x)); o0.y = pk2(x[0][2] * rs * bflo(g0.y), x[0][3] * rs * bfhi(g0.y));
            o0.z = pk2(x[1][0] * rs * bflo(g0.z), x[1][1] * rs * bfhi(g0.z)); o0.w = pk2(x[1][2] * rs * bflo(g0.w), x[1][3] * rs * bfhi(g0.w));
            o1.x = pk2(x[2][0] * rs * bflo(g1.x), x[2][1] * rs * bfhi(g1.x)); o1.y = pk2(x[2][2] * rs * bflo(g1.y), x[2][3] * rs * bfhi(g1.y));
            o1.z = pk2(x[3][0] * rs * bflo(g1.z), x[3][1] * rs * bfhi(g1.z)); o1.w = pk2(x[3][2] * rs * bflo(g1.w), x[3][3] * rs * bfhi(g1.w));
            if (!dry) { *(u32x4v*)(Qg + goff) = o0; *(u32x4v*)(Qg + goff + 8) = o1; }
        }
        __syncthreads();
        if (u + F.G < 2048) { HC_WRITE_S(); if (u + 2 * F.G < 2048) HC_ISSUE(u + 2 * F.G); }
    }
#undef HC_WRITE_A
#undef HC_WRITE_S
}

constexpr int AL_K0 = 0, AL_K1 = 17408, AL_V0 = 34816  , AL_BT = 96256  ;
constexpr int VSTR = 160;
constexpr int KST = 136;

__device__ __forceinline__ void attn_phase(const Frame& F, int L, int dry, int knob) {
    const bf16* Qg = (const bf16*)(F.ws + WS_Q); const bf16* Kg = (const bf16*)(F.ws + WS_UX); const bf16* Vg = (const bf16*)(F.ws + WS_VB); bf16* Og = (bf16*)(F.ws + WS_Q);
    const float* btg = (const float*)(F.ws + WS_CTL + CTL_BT);
    const int tid = F.tid, lane = F.lane, wid = F.wave, r = lane & 31, hh = lane >> 5;
    const int m = wid & 1, qs = wid >> 1;
    LAS float* BT = (LAS float*)(F.lds3 + AL_BT);
    const float lam = ((const float*)(F.ws + WS_CTL + CTL_LAM))[L - 2];
    const int NU = 1024;
    const int vcu = ((F.G & 7) == 0) ? (F.bid & 7) * (F.G >> 3) + (F.bid >> 3) : F.bid;
    const bool seam = (F.G == 256);
    for (int Lu = vcu; Lu < NU; Lu += F.G) {
        const int rnd = Lu >> 8, j = Lu & 255, bh = j >> 4, jj = j & 15;
        const int qb = (rnd == 0) ? 63 - jj : (rnd == 1) ? 32 + jj : (rnd == 2) ? 31 - jj : jj;
        const int b = bh >> 3, h = bh & 7;
        const int NT = 2 * qb + 2, qc = 2 * qb + (qs >> 1), my_nt = qc + 1;
        const size_t rowb = (size_t)b * SEQ;
        BT[tid] = btg[h * 512 + tid];
        const int q0 = qb * 128 + qs * 32;
        bf16x8 qf[4];
#pragma unroll
        for (int ks = 0; ks < 4; ++ks) qf[ks] = *(const bf16x8*)(Qg + (rowb + q0 + r) * D + h * 128 + m * 64 + 16 * ks + 8 * hh);
        f32x16 O[4];
#pragma unroll
        for (int vt = 0; vt < 4; ++vt) O[vt] = (f32x16){};
        float mref = 0.f, lrun = 0.f; f32x16 negm = (f32x16){};
        bf16x8 pf[4];
        const int lag = wid >> 2;
        const int i16 = lane & 15, q4 = i16 >> 2, p4 = i16 & 3, blk = (lane >> 4) & 1;
        const int vlane_off = (4 * hh + q4) * (VSTR * 2) + 32 * blk + 8 * p4;
#define PVD 2
#define PV_RD(i) do { fl[i] = vtr(vbase + (16 * ((i) & 3)) * (VSTR * 2) + 64 * ((i) >> 2)); fh[i] = vtr(vbase + (16 * ((i) & 3) + 8) * (VSTR * 2) + 64 * ((i) >> 2)); } while (0)
#define PV_TILE(slot) do { LAS const unsigned char* vbase = F.lds3 + AL_V0 + (slot) * 20480 + vlane_off; s16x4 fl[16], fh[16]; \
            _Pragma("unroll") for (int i = 0; i < PVD; ++i) PV_RD(i); \
            _Pragma("unroll") for (int i = 0; i < 16; ++i) { if (i + PVD < 16) PV_RD(i + PVD); \
                const bf16x8 vf = __builtin_shufflevector(fl[i], fh[i], 0, 1, 2, 3, 4, 5, 6, 7); __builtin_amdgcn_s_setprio(1); O[i >> 2] = MFMA32(vf, pf[i & 3], O[i >> 2]); __builtin_amdgcn_s_setprio(0); } } while (0)
        u32x4v kr[2], vr[2];
        const int ls = tid >> 4, lc = tid & 15;
#define LOAD_TILE(kt) do { _Pragma("unroll") for (int i = 0; i < 2; ++i) { const size_t off = (rowb + 64 * (kt) + ls + 32 * i) * D + h * 128 + 8 * lc; \
            kr[i] = *(const u32x4v*)(Kg + off); vr[i] = *(const u32x4v*)(Vg + off); } } while (0)
#define ST_WRITE(kb_, vb_) do { _Pragma("unroll") for (int i = 0; i < 2; ++i) { *(LAS u32x4v*)((kb_) + ((ls + 32 * i) * KST + 8 * lc) * 2) = kr[i]; *(LAS u32x4v*)((vb_) + ((ls + 32 * i) * VSTR + 8 * lc) * 2) = vr[i]; } } while (0)
        if (!(seam && Lu != vcu)) LOAD_TILE(0);
        ST_WRITE(F.lds3 + AL_K0, F.lds3 + AL_V0);
        LOAD_TILE(1);
        const int qoff = (qs & 1) * 32 + r;
        int vs = 0, vp = 2;
        for (int kt = 0; kt < NT; ++kt) {
            LAS unsigned char* Kb = F.lds3 + ((kt & 1) ? AL_K1 : AL_K0);
            __syncthreads();
            if (kt + 1 < NT) { const int vn = (vs == 2) ? 0 : vs + 1;
                ST_WRITE(F.lds3 + ((kt & 1) ? AL_K0 : AL_K1), F.lds3 + AL_V0 + vn * 20480);
                if (kt + 2 < NT) LOAD_TILE(kt + 2); }
            if (lag && kt > 0) PV_TILE(vp);
            if (kt < my_nt) {
                const LAS bf16* Kt = (const LAS bf16*)Kb;
                f32x16 S0, S1;
                {
                    const bf16x8 a0 = *(const LAS bf16x8*)(Kt + r * KST + m * 64 + 8 * hh);
                    const bf16x8 a1 = *(const LAS bf16x8*)(Kt + (32 + r) * KST + m * 64 + 8 * hh);
                    S0 = MFMA32(a0, qf[0], negm); S1 = MFMA32(a1, qf[0], negm);
                }
#pragma unroll
                for (int ks = 1; ks < 4; ++ks) {
                    const bf16x8 a0 = *(const LAS bf16x8*)(Kt + r * KST + m * 64 + 16 * ks + 8 * hh);
                    const bf16x8 a1 = *(const LAS bf16x8*)(Kt + (32 + r) * KST + m * 64 + 16 * ks + 8 * hh);
                    S0 = MFMA32(a0, qf[ks], S0); S1 = MFMA32(a1, qf[ks], S1);
                }
                const int delta = qc - kt;
                if (delta <= 2) {
                    const LAS float* bp = BT + m * 256 + (192 - 64 * delta - qoff);
#pragma unroll
                    for (int i = 0; i < 16; ++i) { S0[i] += bp[crow(i, hh)]; S1[i] += bp[32 + crow(i, hh)]; }
                }
                float mx = __builtin_fmaxf(__builtin_fmaxf(S0[0], S1[0]), S0[1]), mx2 = __builtin_fmaxf(__builtin_fmaxf(S1[1], S0[2]), S1[2]);
#pragma unroll
                for (int i = 3; i < 15; i += 2) { mx = __builtin_fmaxf(__builtin_fmaxf(mx, S0[i]), S1[i]); mx2 = __builtin_fmaxf(__builtin_fmaxf(mx2, S0[i + 1]), S1[i + 1]); }
                mx = __builtin_fmaxf(__builtin_fmaxf(mx, S0[15]), S1[15]); mx = __builtin_fmaxf(mx, mx2);
                { auto rr = __builtin_amdgcn_permlane32_swap(__float_as_uint(mx), __float_as_uint(mx), false, false); mx = __builtin_fmaxf(__uint_as_float(rr[0]), __uint_as_float(rr[1])); }
                if (kt == 0 || __any(mx > 8.f)) {
                    const float dl = (kt == 0) ? mx : fmaxf(mx, 0.f);
                    mref += dl;
                    const float f = __builtin_amdgcn_exp2f(-dl);
                    lrun *= f;
#pragma unroll
                    for (int i = 0; i < 16; ++i) { S0[i] -= dl; S1[i] -= dl; negm[i] = -mref; }
#pragma unroll
                    for (int vt = 0; vt < 4; ++vt)
#pragma unroll
                        for (int i = 0; i < 16; ++i) O[vt][i] *= f;
                }
                f32x2 ls2 = {0.f, 0.f};
#pragma unroll
                for (int i = 0; i < 16; i += 2) {
                    S0[i] = __builtin_amdgcn_exp2f(S0[i]); S0[i + 1] = __builtin_amdgcn_exp2f(S0[i + 1]);
                    S1[i] = __builtin_amdgcn_exp2f(S1[i]); S1[i + 1] = __builtin_amdgcn_exp2f(S1[i + 1]);
                    ls2 += (f32x2){S0[i], S0[i + 1]}; ls2 += (f32x2){S1[i], S1[i + 1]}; }
                lrun += ls2[0] + ls2[1];
                { u32x4v w;
                  w.x = pk2(S0[0], S0[1]); w.y = pk2(S0[2], S0[3]); w.z = pk2(S0[4], S0[5]); w.w = pk2(S0[6], S0[7]); pf[0] = __builtin_bit_cast(bf16x8, w);
                  w.x = pk2(S0[8], S0[9]); w.y = pk2(S0[10], S0[11]); w.z = pk2(S0[12], S0[13]); w.w = pk2(S0[14], S0[15]); pf[1] = __builtin_bit_cast(bf16x8, w);
                  w.x = pk2(S1[0], S1[1]); w.y = pk2(S1[2], S1[3]); w.z = pk2(S1[4], S1[5]); w.w = pk2(S1[6], S1[7]); pf[2] = __builtin_bit_cast(bf16x8, w);
                  w.x = pk2(S1[8], S1[9]); w.y = pk2(S1[10], S1[11]); w.z = pk2(S1[12], S1[13]); w.w = pk2(S1[14], S1[15]); pf[3] = __builtin_bit_cast(bf16x8, w); }
                if (!lag) PV_TILE(vs);
            }
            vp = vs; vs = (vs == 2) ? 0 : vs + 1;
        }
        if (seam && Lu + F.G < NU) LOAD_TILE(0);
        if (lag) PV_TILE(vp);
#undef PV_TILE
#undef PV_RD
#undef PVD
#undef LOAD_TILE
#undef ST_WRITE
        __syncthreads();
        const float ltot = lrun + __shfl_xor(lrun, 32), inv = 1.f / ltot;
        LAS float* XCH = (LAS float*)(F.lds3) + qs * 4096;
        if (m == 1) { const float sc = -lam * inv;
#pragma unroll
            for (int vt = 0; vt < 4; ++vt)
#pragma unroll
                for (int i = 0; i < 16; ++i) XCH[(vt * 16 + i) * 64 + lane] = O[vt][i] * sc; }
        __syncthreads();
        if (m == 0) {
            float ss = 0.f;
#pragma unroll
            for (int vt = 0; vt < 4; ++vt)
#pragma unroll
                for (int i = 0; i < 16; ++i) { const float v = O[vt][i] * inv + XCH[(vt * 16 + i) * 64 + lane]; O[vt][i] = v; ss += v * v; }
            ss += __shfl_xor(ss, 32);
            const float rs = rsqrtf(ss * (1.f / 128.f) + EPS);
            LAS bf16* STG = (LAS bf16*)(F.lds3 + qs * 16384);
#pragma unroll
            for (int vt = 0; vt < 4; ++vt)
#pragma unroll
                for (int g4 = 0; g4 < 4; ++g4) { u32x2v w; w.x = pk2(O[vt][4 * g4] * rs, O[vt][4 * g4 + 1] * rs); w.y = pk2(O[vt][4 * g4 + 2] * rs, O[vt][4 * g4 + 3] * rs);
                    *(LAS u32x2v*)(STG + r * KST + 32 * vt + 8 * g4 + 4 * hh) = w; }
            __builtin_amdgcn_s_waitcnt(0xc07f); asm volatile("" ::: "memory");
#pragma unroll
            for (int i2 = 0; i2 < 8; ++i2) { const int idx = lane + 64 * i2, row = idx >> 4, cq = idx & 15;
                if (!dry) *(u32x4v*)(Og + (rowb + q0 + row) * D + h * 128 + 8 * cq) = *(const LAS u32x4v*)(STG + row * KST + 8 * cq); }
        }
        __syncthreads();
    }
}

#define XB_TMO      128
#define XB_XCNT(j)  (256  + 64 * (j))
#define XB_XSUB(j)  (1280 + 64 * (j))
#define XB_XGEN(j)  (2304 + 64 * (j))
#define XB_TOP      3328
#define XB_TOPGEN   3392
#define XCD_BAR_WORDS 3456
#define XB_SPIN_CAP (1u << 18)

__device__ __forceinline__ unsigned xb_ld(unsigned* p)              { return __hip_atomic_load(p, __ATOMIC_RELAXED, __HIP_MEMORY_SCOPE_AGENT); }
__device__ __forceinline__ unsigned xb_add(unsigned* p, unsigned v) { return __hip_atomic_fetch_add(p, v, __ATOMIC_RELAXED, __HIP_MEMORY_SCOPE_AGENT); }
__device__ __forceinline__ unsigned xb_xcc_id() { return (unsigned)__builtin_amdgcn_s_getreg((3 << 11) | 20) & 0xFu; }
#define XB_SPIN(cond, bar) do { unsigned _sp = 0; while (cond) { __builtin_amdgcn_s_sleep(1); \
    if ((++_sp & 255u) == 0u) { if (xb_ld(&(bar)[XB_TMO])) break; if (_sp > XB_SPIN_CAP) { atomicAdd(&(bar)[XB_TMO], 1u); break; } } } } while (0)

struct XcdBarrier {
    unsigned* bar; unsigned x;
    volatile LAS unsigned* st;
};

__device__ __forceinline__ XcdBarrier xcd_barrier_post(unsigned* bar, volatile LAS unsigned* st) {
    XcdBarrier b; b.bar = bar; b.x = xb_xcc_id(); b.st = st;
    if (threadIdx.x == 0) (void)xb_add(&bar[XB_XCNT(b.x)], 1u);
    return b;
}
__device__ __forceinline__ void xcd_barrier_complete(unsigned* bar, unsigned x, unsigned& nloc, unsigned& nx) {
    const unsigned G = gridDim.x * gridDim.y * gridDim.z;
    unsigned sum, cnt, mine, sp = 0u;
    for (;;) {
        sum = 0u; cnt = 0u; mine = 0u;
#pragma unroll
        for (unsigned j = 0; j < 16; ++j) { const unsigned c = xb_ld(&bar[XB_XCNT(j)]); sum += c; cnt += (c > 0u) ? 1u : 0u; mine = (j == x) ? c : mine; }
        if (sum == G) break;
        __builtin_amdgcn_s_sleep(1);
        if ((++sp & 255u) == 0u) { if (xb_ld(&bar[XB_TMO])) break; if (sp > XB_SPIN_CAP) { atomicAdd(&bar[XB_TMO], 1u); break; } }
    }
    nloc = mine > 0u ? mine : 1u; nx = cnt > 0u ? cnt : 1u;
}

__device__ __forceinline__ void xcd_barrier(const XcdBarrier& b) {
    asm volatile("s_waitcnt vmcnt(0)" ::: "memory");
    __syncthreads();
    if (threadIdx.x == 0) {
        unsigned* bar = b.bar;
        __builtin_amdgcn_s_waitcnt(0);
        unsigned nloc = b.st[0], nx = b.st[1];
        if (nloc == 0u) { xcd_barrier_complete(bar, b.x, nloc, nx); b.st[0] = nloc; b.st[1] = nx; }
        const unsigned old = xb_add(&bar[XB_XSUB(b.x)], 1u);
        const unsigned gen = old / nloc;
        if (old + 1u == (gen + 1u) * nloc) {
            __builtin_amdgcn_fence(__ATOMIC_RELEASE, "agent");
            asm volatile("s_waitcnt vmcnt(0)" ::: "memory");
            const unsigned og = xb_add(&bar[XB_TOP], 1u);
            const unsigned tg = og / nx;
            if (og + 1u == (tg + 1u) * nx) xb_add(&bar[XB_TOPGEN], 1u);
            else XB_SPIN(xb_ld(&bar[XB_TOPGEN]) == tg, bar);
            __builtin_amdgcn_fence(__ATOMIC_ACQUIRE, "agent");
            xb_add(&bar[XB_XGEN(b.x)], 1u);
            asm volatile("s_waitcnt vmcnt(0)" ::: "memory");
        } else {
            XB_SPIN(xb_ld(&bar[XB_XGEN(b.x)]) == gen, bar);
            __builtin_amdgcn_fence(__ATOMIC_ACQUIRE, "agent");
            asm volatile("s_waitcnt vmcnt(0)" ::: "memory");
        }
    }
    __syncthreads();
}

__global__ void __launch_bounds__(512, 2) yoco_fwd(Args args) {
    extern __shared__ __attribute__((aligned(16))) unsigned char lds[];
    volatile LAS unsigned* bst = (volatile LAS unsigned*)((LAS unsigned char*)lds + 131072);
    if (threadIdx.x < 2) bst[threadIdx.x] = 0u;
    __syncthreads();
    if (args.hi - args.lo > 1) (void)xcd_barrier_post((unsigned*)(args.ws + WS_CTL + CTL_BAR), bst);
    for (int ph = args.lo; ph < args.hi; ++ph) {
        int tid_ = threadIdx.x; asm volatile("" : "+v"(tid_));
        size_t zoff_ = 0; asm volatile("" : "+s"(zoff_)); unsigned char* ws = args.ws + zoff_;
        int z_ = 0; asm volatile("" : "+s"(z_));
        Frame F;
        F.lds = lds; F.lds3 = (LAS unsigned char*)lds;
        F.tid = tid_; F.lane = F.tid & 63; F.wave = __builtin_amdgcn_readfirstlane(F.tid >> 6);
        F.G = gridDim.x; F.bid = blockIdx.x; F.in = args.in + z_; F.H = (args.out + zoff_); F.ws = ws;
        bf16* WA = (bf16*)(ws + WS_W + W_A); bf16* WO = (bf16*)(ws + WS_W + W_O); bf16* WU = (bf16*)(ws + WS_W + W_U); bf16* WD = (bf16*)(ws + WS_W + W_D);
        bf16* XN = (bf16*)(ws + WS_XN); bf16* QB = (bf16*)(ws + WS_Q); bf16* HID = (bf16*)(ws + WS_HID);
        float* STAT = (float*)(ws + WS_STAT);
        const int kind = args.kind[ph], L = args.layer[ph] & 15, dry = args.layer[ph] >> 7, knob = (args.layer[ph] >> 4) & 7;
        switch (kind) {
        case K_PRO: {
            prologue_tables(F);
            norm_pass(F, F.in[0], nullptr, nullptr, nullptr, nullptr, XN);
        } break;
#ifndef SKIP_WIN
        case K_WIN: {
            pg8::Gemm g{XN, WA, M, 4096, D}; pg8::StaticOrder S; S.init(M, 4096, F.G, F.bid);
            EpiWin E{ws, (const float*)(ws + WS_CTL + CTL_LBT) + (size_t)L * 2048};
            pg8::gemm_phase<EpiWin, pg8::StaticOrder, true, true>(F.lds3, g, S, E, F.tid);
        } break;
#endif
        #ifndef SKIP_HA
        case K_HA: hgrn_pass_a(F); break;
#endif
        #ifndef SKIP_HB
        case K_HB: hgrn_pass_b(F, dry); break;
#endif
        #ifndef SKIP_HC
        case K_HC: hgrn_pass_c(F, dry); break;
#endif
#ifndef SKIP_UP
        case K_UP: {
            pg8::Gemm g{XN, WU, M, FF, D}; pg8::StaticOrder S; S.init(M, FF, F.G, F.bid);
            EpiRelu2 E{HID};
            pg8::gemm_phase<EpiRelu2, pg8::StaticOrder, true, true>(F.lds3, g, S, E, F.tid);
        } break;
#endif
#ifndef SKIP_KVQ
        case K_KVQ: case K_QG: {
            const int N = (kind == K_KVQ) ? 3072 : 1024;
            pg8::Gemm g{XN, WA, M, N, D}; pg8::StaticOrder S; S.init(M, N, F.G, F.bid);
            EpiSplit E{ws, kind == K_KVQ ? 1 : 0};
            pg8::gemm_phase<EpiSplit, pg8::StaticOrder, true, true>(F.lds3, g, S, E, F.tid);
        } break;
#endif
        #ifndef SKIP_ATT
        case K_ATT: attn_phase(F, L, dry, knob); break;
#endif
        case K_YOUTF: case K_DOWNF: {
            const int isd = (kind == K_DOWNF) ? 1 : 0, use = (L * 2 + isd) * 2;
            const float* wpost = isd ? F.in[17] + L * D : ((L < 2) ? F.in[2] + L * D : F.in[10] + (L - 2) * D);
            float* Hp = args.out + zoff_;
            const float* hin = (L == 0 && !isd) ? F.in[0] : Hp;
            unsigned* cntb = (unsigned*)(ws + WS_CTL + CTL_CNT);
            EpiNormF E{hin, Hp, (isd && L == 3) ? nullptr : XN, wpost,
                       RowStatX{(float*)(ws + WS_STAT), cntb + (size_t)use * 4096}, RowStatX{(float*)(ws + WS_STAT + 262144), cntb + (size_t)(use + 1) * 4096}};
            pg8::StaticOrder S; S.init(M, D, F.G, F.bid);
            if (isd) { pg8::Gemm g{HID, WD, M, D, FF}; pg8::gemm_phase<EpiNormF, pg8::StaticOrder, false, true>(F.lds3, g, S, E, F.tid); }
            else { pg8::Gemm g{QB, WO, M, D, D}; pg8::gemm_phase<EpiNormF, pg8::StaticOrder, false, true>(F.lds3, g, S, E, F.tid); }
        } break;
        default: break;
        }
        { const int cvb = args.cv[ph]; if (cvb) { __syncthreads(); convert_layer(F, cvb >> 4, cvb & 15); } }
        if (ph + 1 < args.hi) {
            if (args.hi < 0) { __syncthreads(); cg::this_grid().sync(); }
            XcdBarrier bar; bar.bar = (unsigned*)(ws + WS_CTL + CTL_BAR); bar.x = xb_xcc_id(); bar.st = bst; xcd_barrier(bar);
        }
    }
}

#ifndef N_LAUNCH_MODE
#define N_LAUNCH_MODE 0
#endif
extern "C" void kernel_launch(void* const* d_in, const int* in_sizes, int n_in, void* d_out, int out_size, void* d_ws, size_t ws_size, hipStream_t stream) {
    static int grid = 0;
    if (grid == 0) {
        int dev = 0, cus = 0, per_cu = 0;
        (void)hipGetDevice(&dev); (void)hipDeviceGetAttribute(&cus, hipDeviceAttributeMultiprocessorCount, dev);
        (void)hipFuncSetAttribute((const void*)yoco_fwd, hipFuncAttributeMaxDynamicSharedMemorySize, LDS_TOTAL);
        (void)hipOccupancyMaxActiveBlocksPerMultiprocessor(&per_cu, (const void*)yoco_fwd, 512, LDS_TOTAL);
        (void)hipGetLastError();
        if (per_cu < 1) per_cu = 1;
        grid = cus > 0 ? cus : 256;
        if (ws_size < 252 * MiB) fprintf(stderr, "kernel_launch: workspace too small (%zu)\n", ws_size);
    }
    (void)hipMemsetAsync((unsigned char*)d_ws + WS_CTL + CTL_BAR, 0, CTL_ZERO_END - CTL_BAR, stream);
    Args a{};
    for (int i = 0; i < 20; ++i) a.in[i] = (const float*)d_in[i];
    a.out = (float*)d_out; a.ws = (unsigned char*)d_ws;
    int n = 0;
#ifndef PROBE_MASK
#define PROBE_MASK 0
#endif
#ifndef PROBE_KNOB
#define PROBE_KNOB 0
#endif
    auto add = [&](int k, int l, int cvb = 0) { if ((PROBE_MASK >> k) & 1) { a.kind[n] = (unsigned char)k; a.layer[n] = (unsigned char)(l | 128 | (PROBE_KNOB << 4)); a.cv[n] = 0; ++n; }
                                   a.kind[n] = (unsigned char)k; a.layer[n] = (unsigned char)l; a.cv[n] = (unsigned char)cvb; ++n; };
    add(K_PRO, 0, 15);
    {
        for (int L = 0; L < 2; ++L) { add(K_WIN, L, L == 1 ? ((1 << 4) | 8) : 0); add(K_HA, L); add(K_HB, L); add(K_HC, L); add(K_YOUTF, L); add(K_UP, L); add(K_DOWNF, L, ((L + 1) << 4) | 7); }
        add(K_KVQ, 2, (2 << 4) | 8);
        for (int L = 2; L < 4; ++L) { if (L == 3) add(K_QG, L, (3 << 4) | 8); add(K_ATT, L); add(K_YOUTF, L); add(K_UP, L); add(K_DOWNF, L, L < 3 ? (((L + 1) << 4) | 7) : 0); }
    }
#if N_LAUNCH_MODE == 0
    a.lo = 0; a.hi = n;
    void* kargs[] = {&a};
    hipError_t e = hipLaunchCooperativeKernel((const void*)yoco_fwd, dim3(grid), dim3(512), kargs, LDS_TOTAL, stream);
    if (e != hipSuccess) fprintf(stderr, "cooperative launch failed: %s (grid %d)\n", hipGetErrorString(e), grid);
#else
    for (int p = 0; p < n; ++p) { a.lo = p; a.hi = p + 1; hipLaunchKernelGGL(yoco_fwd, dim3(grid), dim3(512), LDS_TOTAL, stream, a); }
#endif
}
```
